# Optimizing an MI355X kernel written in HIP

```python
import math
import jax, jax.numpy as jnp
from jax import lax
import numpy as np

D_MODEL = 1024
BATCH = 4
SEQ = 4096
DEPTH = 2

D_MIX = D_MODEL
EPS = 1e-6
NEG = -1e30
FORCE = 1e6
F_FLOOR = 1e-30
NSA_HEADS = 8
NSA_KV_GROUPS = 2
NSA_HD = 64
CMP_LEN = 32
CMP_STRIDE = 16
CMP_HID = 256
SEL_BLOCK = 64
SEL_TOPK = 16
SEL_QBLOCK = 32
WINDOW = 512
WIN_QBLOCK = 128
HG_HEADS = 4
HG_DK = 128
HG_DV = 128
HG_CHUNK = 64
D_FF = 2752

NSA_WIDTH = NSA_HEADS * NSA_HD
HG_WIDTH = HG_HEADS * HG_DV
KV_W = NSA_KV_GROUPS * NSA_HD
IN_SIZES = (NSA_WIDTH, KV_W, KV_W, KV_W, KV_W, KV_W, KV_W, NSA_HEADS * 3,
            HG_HEADS * HG_DK, HG_HEADS * HG_DK, HG_WIDTH, HG_WIDTH)
IN_COLS = sum(IN_SIZES)
IN_SPLITS = tuple(int(v) for v in np.cumsum(IN_SIZES)[:-1])

kernel_name = "hymba_nsa_hgrn2_macaron_alibi"


def rms_norm(x, g):
    xf = x.astype(jnp.float32)
    y = xf * lax.rsqrt(jnp.mean(xf * xf, axis=-1, keepdims=True) + EPS)
    return (y * g.astype(jnp.float32)).astype(x.dtype)


def swiglu(x, w_gu, w_down):
    gate, up = jnp.split(x @ w_gu, 2, axis=-1)
    return (jax.nn.silu(gate) * up) @ w_down


def alibi_slopes(n):
    return jnp.asarray([2.0 ** (-8.0 * (i + 1) / n) for i in range(n)], dtype=jnp.float32)


def compress(kv, pos_emb, w1, w2):
    B, S, G, dk = kv.shape
    chunks = kv.reshape(B, S // CMP_STRIDE, CMP_STRIDE, G, dk)
    blocks = jnp.concatenate([chunks[:, :-1], chunks[:, 1:]], axis=2) + pos_emb[:, None, :]
    nb = blocks.shape[1]
    flat = blocks.transpose(0, 1, 3, 2, 4).reshape(B, nb, G, CMP_LEN * dk)
    return jax.nn.gelu(flat @ w1) @ w2


def nsa_group(q, k_c, v_c, k_s, v_s, k_w, v_w, gate_logits,
              cmp_pos_k, cmp_pos_v, cmp_k_w1, cmp_k_w2, cmp_v_w1, cmp_v_w2):
    B, S = q.shape[:2]
    G, Hg, dk = NSA_KV_GROUPS, NSA_HEADS // NSA_KV_GROUPS, NSA_HD
    scale = dk ** -0.5
    slopes = alibi_slopes(NSA_HEADS).reshape(G, Hg)
    q5 = q.reshape(B, S, G, Hg, dk)
    kv4 = lambda t: t.reshape(B, S, G, dk)
    pos = jnp.arange(S, dtype=jnp.int32)

    kc = compress(kv4(k_c), cmp_pos_k, cmp_k_w1, cmp_k_w2)
    vc = compress(kv4(v_c), cmp_pos_v, cmp_v_w1, cmp_v_w2)
    nb = kc.shape[1]
    blk_end = jnp.arange(nb, dtype=jnp.int32) * CMP_STRIDE + (CMP_LEN - 1)
    dist_c = pos[:, None] - blk_end[None, :]
    s_c = jnp.einsum('bsgnd,bcgd->bsgnc', q5, kc).astype(jnp.float32) * scale
    s_c = s_c - slopes[:, :, None] * dist_c.astype(jnp.float32)[:, None, None, :]
    s_c = jnp.where((dist_c >= 0)[:, None, None, :], s_c, NEG)
    p_c = jax.nn.softmax(s_c, axis=-1)
    p_c = jnp.where((pos >= CMP_LEN - 1)[:, None, None, None], p_c, 0.0)
    o_cmp = jnp.einsum('bsgnc,bcgd->bsgnd', p_c.astype(vc.dtype), vc)

    imp = p_c.sum(axis=3)
    padded = jnp.pad(imp, ((0, 0), (0, 0), (0, 0), (1, 1)))
    chunk_imp = padded[..., :-1] + padded[..., 1:]
    ns = S // SEL_BLOCK
    p_slc = chunk_imp.reshape(B, S, G, ns, SEL_BLOCK // CMP_STRIDE).sum(-1)
    blk = jnp.arange(ns, dtype=jnp.int32)
    cur = pos // SEL_BLOCK
    forced = (blk[None] == 0) | (blk[None] == cur[:, None]) | (blk[None] == cur[:, None] - 1)
    causal = blk[None] * SEL_BLOCK <= pos[:, None]
    score = jnp.where(forced[:, None], FORCE, jnp.where(causal[:, None], p_slc, NEG))
    n_sel = min(SEL_TOPK, ns)
    _, sel_idx = lax.top_k(score, n_sel)

    k_blocks = kv4(k_s).reshape(B, ns, SEL_BLOCK, G, dk).transpose(0, 3, 1, 2, 4)
    v_blocks = kv4(v_s).reshape(B, ns, SEL_BLOCK, G, dk).transpose(0, 3, 1, 2, 4)
    nq = S // SEL_QBLOCK
    b_ix = jnp.arange(B)[:, None, None, None]
    g_ix = jnp.arange(G)[None, None, :, None]
    l_ar = jnp.arange(SEL_BLOCK, dtype=jnp.int32)

    def sel_step(args):
        qb, idx, qi = args
        kg = k_blocks[b_ix, g_ix, idx]
        vg = v_blocks[b_ix, g_ix, idx]
        s = jnp.einsum('btgnd,btgkld->btgnkl', qb, kg).astype(jnp.float32) * scale
        qpos = qi * SEL_QBLOCK + jnp.arange(SEL_QBLOCK, dtype=jnp.int32)
        kpos = idx[..., None] * SEL_BLOCK + l_ar
        dist = qpos[None, :, None, None, None] - kpos
        s = s - slopes[None, None, :, :, None, None] * dist.astype(jnp.float32)[:, :, :, None]
        s = jnp.where((dist >= 0)[:, :, :, None], s, NEG)
        p = jax.nn.softmax(s.reshape(s.shape[:4] + (-1,)), axis=-1).reshape(s.shape)
        return jnp.einsum('btgnkl,btgkld->btgnd', p.astype(vg.dtype), vg)

    o_sel = lax.map(sel_step, (q5.reshape(B, nq, SEL_QBLOCK, G, Hg, dk).swapaxes(0, 1),
                               sel_idx.reshape(B, nq, SEL_QBLOCK, G, n_sel).swapaxes(0, 1),
                               jnp.arange(nq, dtype=jnp.int32)))
    o_sel = o_sel.swapaxes(0, 1).reshape(B, S, G, Hg, dk)

    nwq = S // WIN_QBLOCK
    n_kb = WINDOW // WIN_QBLOCK + 1
    kw_len = n_kb * WIN_QBLOCK

    def band(t):
        tp = jnp.pad(kv4(t), ((0, 0), (WINDOW, 0), (0, 0), (0, 0)))
        tp = tp.reshape(B, nwq + WINDOW // WIN_QBLOCK, WIN_QBLOCK, G, dk)
        return jnp.concatenate([tp[:, j:j + nwq] for j in range(n_kb)], axis=2).swapaxes(0, 1)

    def win_step(args):
        qb, kb, vb, qi = args
        s = jnp.einsum('btgnd,bkgd->btgnk', qb, kb).astype(jnp.float32) * scale
        qpos = qi * WIN_QBLOCK + jnp.arange(WIN_QBLOCK, dtype=jnp.int32)
        kpos = qi * WIN_QBLOCK - WINDOW + jnp.arange(kw_len, dtype=jnp.int32)
        dist = qpos[:, None] - kpos[None, :]
        valid = (dist >= 0) & (dist < WINDOW) & (kpos >= 0)[None, :]
        s = s - slopes[None, None, :, :, None] * dist.astype(jnp.float32)[None, :, None, None, :]
        s = jnp.where(valid[None, :, None, None, :], s, NEG)
        p = jax.nn.softmax(s, axis=-1)
        return jnp.einsum('btgnk,bkgd->btgnd', p.astype(vb.dtype), vb)

    o_win = lax.map(win_step, (q5.reshape(B, nwq, WIN_QBLOCK, G, Hg, dk).swapaxes(0, 1),
                               band(k_w), band(v_w), jnp.arange(nwq, dtype=jnp.int32)))
    o_win = o_win.swapaxes(0, 1).reshape(B, S, G, Hg, dk)

    g = jax.nn.sigmoid(gate_logits.astype(jnp.float32)).reshape(B, S, G, Hg, 3)
    o = (g[..., 0:1] * o_cmp.astype(jnp.float32) + g[..., 1:2] * o_sel.astype(jnp.float32)
         + g[..., 2:3] * o_win.astype(jnp.float32))
    return o.reshape(B, S, NSA_WIDTH).astype(q.dtype)


def hgrn2_group(q, f_logit, i_in, g_in, lower_bound, out_norm):
    B, S = q.shape[:2]
    H, dk, dv, C = HG_HEADS, HG_DK, HG_DV, HG_CHUNK
    qf = jax.nn.silu(q.astype(jnp.float32)).reshape(B, S, H, dk)
    lb = lower_bound.astype(jnp.float32)
    z = f_logit.astype(jnp.float32)
    f = lb + (1.0 - lb) * jax.nn.sigmoid(z)
    logf = jnp.log(jnp.maximum(f, F_FLOOR)).reshape(B, S, H, dk)
    kf = ((1.0 - lb) * jax.nn.sigmoid(-z)).reshape(B, S, H, dk)
    vf = i_in.astype(jnp.float32).reshape(B, S, H, dv)
    nc = S // C
    to_chunks = lambda t: t.reshape(B, nc, C, H, t.shape[-1]).transpose(1, 0, 3, 2, 4)
    tril = jnp.tril(jnp.ones((C, C), dtype=bool))

    def step(state, inp):
        qc, kc, vc, lf = inp
        b = jnp.cumsum(lf, axis=2)
        decay = b[:, :, :, None, :] - b[:, :, None, :, :]
        decay = jnp.exp(jnp.where(tril[:, :, None], decay, NEG))
        a = jnp.einsum('bhtd,bhtsd,bhsd->bhts', qc, decay, kc)
        o_intra = jnp.einsum('bhts,bhsv->bhtv', a, vc)
        o_inter = jnp.einsum('bhtd,bhdv->bhtv', qc * jnp.exp(b), state)
        b_last = b[:, :, -1]
        new_state = (jnp.exp(b_last)[..., None] * state
                     + jnp.einsum('bhsd,bhsv->bhdv', kc * jnp.exp(b_last[:, :, None] - b), vc))
        return new_state, o_intra + o_inter

    state0 = jnp.zeros((B, H, dk, dv), jnp.float32)
    _, o = lax.scan(step, state0, (to_chunks(qf), to_chunks(kf), to_chunks(vf), to_chunks(logf)))
    o = o.transpose(1, 0, 3, 2, 4).reshape(B, S, H, dv)
    o = o * lax.rsqrt(jnp.mean(o * o, axis=-1, keepdims=True) + EPS) * out_norm.astype(jnp.float32)
    o = o.reshape(B, S, HG_WIDTH) * jax.nn.silu(g_in.astype(jnp.float32))
    return o.astype(q.dtype)


def hybrid_mixer(h, w_in, cmp_pos_k, cmp_pos_v, cmp_k_w1, cmp_k_w2, cmp_v_w1, cmp_v_w2,
                 lower_bound, hg_norm, w_out):
    parts = jnp.split(h @ w_in, IN_SPLITS, axis=-1)
    nq, k_c, v_c, k_s, v_s, k_w, v_w, gl, hq, hf, hi, hg = parts
    o_nsa = nsa_group(nq, k_c, v_c, k_s, v_s, k_w, v_w, gl,
                      cmp_pos_k, cmp_pos_v, cmp_k_w1, cmp_k_w2, cmp_v_w1, cmp_v_w2)
    o_hg = hgrn2_group(hq, hf, hi, hg, lower_bound, hg_norm)
    return jnp.concatenate([o_nsa, o_hg], axis=-1) @ w_out


def setup_inputs(seed: int = 0) -> dict:
    key = jax.random.key(seed)
    ks = jax.random.split(key, 20)
    nrm = lambda k, shape, s: jax.random.normal(k, shape, jnp.float32) * s
    gain = lambda k, shape: 1.0 + 0.02 * jax.random.normal(k, shape, jnp.float32)
    L = DEPTH
    return {
        "x": jax.random.normal(ks[0], (BATCH, SEQ, D_MODEL), jnp.float32),
        "ffn1_norm": gain(ks[1], (L, D_MODEL)),
        "ffn1_w_gu": nrm(ks[2], (L, D_MODEL, 2 * D_FF), D_MODEL ** -0.5),
        "ffn1_w_down": nrm(ks[3], (L, D_FF, D_MODEL), D_FF ** -0.5),
        "mix_norm": gain(ks[4], (L, D_MODEL)),
        "w_in": nrm(ks[5], (L, D_MODEL, IN_COLS), D_MODEL ** -0.5),
        "cmp_pos_k": nrm(ks[6], (L, CMP_LEN, NSA_HD), 0.02),
        "cmp_pos_v": nrm(ks[7], (L, CMP_LEN, NSA_HD), 0.02),
        "cmp_k_w1": nrm(ks[8], (L, CMP_LEN * NSA_HD, CMP_HID), (CMP_LEN * NSA_HD) ** -0.5),
        "cmp_k_w2": nrm(ks[9], (L, CMP_HID, NSA_HD), CMP_HID ** -0.5),
        "cmp_v_w1": nrm(ks[10], (L, CMP_LEN * NSA_HD, CMP_HID), (CMP_LEN * NSA_HD) ** -0.5),
        "cmp_v_w2": nrm(ks[11], (L, CMP_HID, NSA_HD), CMP_HID ** -0.5),
        "hgrn_lower_bound": nrm(ks[12], (L, HG_HEADS * HG_DK), 0.1),
        "hgrn_out_norm": gain(ks[13], (L, HG_DV)),
        "w_out": nrm(ks[14], (L, D_MIX, D_MODEL), D_MIX ** -0.5),
        "ffn2_norm": gain(ks[15], (L, D_MODEL)),
        "ffn2_w_gu": nrm(ks[16], (L, D_MODEL, 2 * D_FF), D_MODEL ** -0.5),
        "ffn2_w_down": nrm(ks[17], (L, D_FF, D_MODEL), D_FF ** -0.5),
        "final_norm": gain(ks[18], (D_MODEL,)),
    }


def reference(x, ffn1_norm, ffn1_w_gu, ffn1_w_down, mix_norm, w_in, cmp_pos_k, cmp_pos_v,
              cmp_k_w1, cmp_k_w2, cmp_v_w1, cmp_v_w2, hgrn_lower_bound, hgrn_out_norm, w_out,
              ffn2_norm, ffn2_w_gu, ffn2_w_down, final_norm):
    lb_sm = jax.nn.softmax(hgrn_lower_bound.astype(jnp.float32), axis=0)
    lower_bounds = jnp.cumsum(lb_sm, axis=0) - lb_sm[0]
    h = x
    for l in range(DEPTH):
        h = h + 0.5 * swiglu(rms_norm(h, ffn1_norm[l]), ffn1_w_gu[l], ffn1_w_down[l])
        h = h + hybrid_mixer(rms_norm(h, mix_norm[l]), w_in[l], cmp_pos_k[l], cmp_pos_v[l],
                             cmp_k_w1[l], cmp_k_w2[l], cmp_v_w1[l], cmp_v_w2[l],
                             lower_bounds[l], hgrn_out_norm[l], w_out[l])
        h = h + 0.5 * swiglu(rms_norm(h, ffn2_norm[l]), ffn2_w_gu[l], ffn2_w_down[l])
    return rms_norm(h, final_norm)
```

```cpp
#include <hip/hip_runtime.h>
#include <hip/hip_cooperative_groups.h>
#include <cstdio>
#include <cstdint>
namespace cg = cooperative_groups;
#ifndef PROBE_REP
#define PROBE_REP 0
#endif
namespace pg8 {
#define PG8_LAS __attribute__((address_space(3)))
typedef unsigned short bf16_t;
typedef short bf16x8 __attribute__((ext_vector_type(8)));
typedef float f32x4 __attribute__((ext_vector_type(4)));
typedef unsigned u32x4 __attribute__((ext_vector_type(4)));
constexpr int BM = 256, BK = 64, HALF = 128, HTB = HALF * BK * 2  , STAGE_BYTES = 8 * HTB, NXCD = 8, WGM = 8;

__host__ __device__ __forceinline__ int lds_byte(int r, int c) { const int st = (r >> 4) * 2 + (c >> 5), rr = r & 15, cc = c & 31, ob = rr * 64 + cc * 2; return st * 1024 + (ob ^ (((ob >> 9) & 1) << 5)); }
__host__ __device__ __forceinline__ void stage_rc(int b, int& R, int& C) { const int st = b / 1024, sb = b % 1024, swz = sb ^ (((sb >> 9) & 1) << 5); R = (st >> 1) * 16 + swz / 64; C = (st & 1) * 32 + (swz % 64) / 2; }
__host__ __device__ __forceinline__ int perm32(int rho) { const int n = rho >> 4, i = rho & 15; return 8 * (i >> 2) + 4 * n + (i & 3); }

struct Unit { int pm, pn; };
struct Gemm { const bf16_t* A; const bf16_t* Bt; int M, N, K; };

struct StaticOrder {
    int nM, nN, nwg, G, c;
    __host__ __device__ void init(int M, int N, int G_, int c_) { nM = M / BM; nN = N / BM; nwg = nM * nN; G = G_; c = c_; }
    __host__ __device__ bool next(int i, Unit& u) const {
        const long L = (long)i * G + c; if (L >= nwg) return false;
        int wgid = (int)L; { const int q = nwg / NXCD, r = nwg % NXCD, xcd = wgid % NXCD, off = wgid / NXCD; wgid = (xcd < r ? xcd * (q + 1) : r * (q + 1) + (xcd - r) * q) + off; }
        const int nig = WGM * nN, gid = wgid / nig, fm = gid * WGM, gsz = (nM - fm) < WGM ? (nM - fm) : WGM;
        u.pm = fm + ((wgid % nig) % gsz); u.pn = (wgid % nig) / gsz; return true;
    }
    __device__ __forceinline__ void a_ready(const Unit&) const {}
    __device__ __forceinline__ void done(const Unit&) const {}
};

__device__ __forceinline__ unsigned cvt_pk_bf16(float lo, float hi) { unsigned r; asm volatile("v_cvt_pk_bf16_f32 %0, %1, %2" : "=v"(r) : "v"(lo), "v"(hi)); return r; }
template <class Epi, class Sched, bool ALIGN_EPI = false, bool SP2 = false>
__device__ __forceinline__ void gemm_phase(PG8_LAS unsigned char* lds, const Gemm g, const Sched& S, const Epi& E) {
    int tid_l = threadIdx.x; asm volatile("" : "+v"(tid_l)); const int tid = tid_l, wid = __builtin_amdgcn_readfirstlane(tid >> 6), lane = tid & 63, wr = wid >> 2, wc = wid & 3, fr = lane & 15, fq = lane >> 4;
    const int K = g.K, nt = K / BK;
    unsigned voffA[2], voffB[2];
#pragma unroll
    for (int i = 0; i < 2; ++i) { int R, C; stage_rc(tid * 16 + i * 8192, R, C); const int Rb = Epi::PERM ? ((R & ~31) + perm32(R & 31)) : R;
        voffA[i] = (unsigned)(R * K + C) * 2u; voffB[i] = (unsigned)(Rb * K + C) * 2u; }
    const size_t kstep = (size_t)(BK * 2);
    const size_t hstep = (size_t)HALF * K * 2;
    const size_t tstep = 2 * hstep;
    const unsigned ldsw = (unsigned)wid * 1024u;
    const int aoff = lds_byte(wr * 64 + fr, fq * 8), boff = lds_byte(wc * 32 + fr, fq * 8);
#define PG8_SA(b, h) (((b) * 2 + (h)) * HTB)
#define PG8_SB(b, h) ((4 + (b) * 2 + (h)) * HTB)
#define PG8_STAGE(bufoff, gbase, voff) do { _Pragma("unroll") for (int _i = 0; _i < 2; ++_i) \
        __builtin_amdgcn_global_load_lds((const unsigned*)((const char*)(gbase) + (voff)[_i]), (PG8_LAS unsigned*)(lds + (bufoff) + ldsw + _i * 8192), 16, 0, 0); } while (0)
#define PG8_LDA(dst, b, h) do { _Pragma("unroll") for (int m = 0; m < 4; ++m) _Pragma("unroll") for (int k = 0; k < 2; ++k) dst[m][k] = *(const PG8_LAS bf16x8*)(lds + PG8_SA(b, h) + aoff + m * 2048 + k * 1024); } while (0)
#define PG8_LDB(dst, b, h) do { _Pragma("unroll") for (int n = 0; n < 2; ++n) _Pragma("unroll") for (int k = 0; k < 2; ++k) dst[n][k] = *(const PG8_LAS bf16x8*)(lds + PG8_SB(b, h) + boff + n * 2048 + k * 1024); } while (0)
#define PG8_MMA(ai, bj, At, Bt) do { __builtin_amdgcn_s_setprio(1); _Pragma("unroll") for (int m = 0; m < 4; ++m) _Pragma("unroll") for (int n = 0; n < 2; ++n) _Pragma("unroll") for (int k = 0; k < 2; ++k) \
        acc[ai][bj][m][n] = __builtin_amdgcn_mfma_f32_16x16x32_bf16(Bt[n][k], At[m][k], acc[ai][bj][m][n], 0, 0, 0); __builtin_amdgcn_s_setprio(0); } while (0)
#define PG8_WAIT_V(n) asm volatile("s_waitcnt vmcnt(" #n ")" ::: "memory")
#define PG8_WAIT_L(n) asm volatile("s_waitcnt lgkmcnt(" #n ")" ::: "memory")
#define PG8_BAR __builtin_amdgcn_s_barrier()
#define PG8_SCHED __builtin_amdgcn_sched_barrier(0)
    Unit cur, nxt; int ui = 0;
    if (!S.next(0, cur)) return;
    f32x4 acc[2][2][4][2];
#pragma unroll
    for (int a = 0; a < 2; ++a)
#pragma unroll
        for (int b = 0; b < 2; ++b)
#pragma unroll
            for (int m = 0; m < 4; ++m)
#pragma unroll
                for (int n = 0; n < 2; ++n) acc[a][b][m][n] = (f32x4){0.f, 0.f, 0.f, 0.f};
    bf16x8 At[4][2], B0[2][2], B1[2][2];
    const char* cA = (const char*)g.A + (size_t)cur.pm * tstep; const char* cB = (const char*)g.Bt + (size_t)cur.pn * tstep;
    S.a_ready(cur);
    if constexpr (SP2) {
        PG8_STAGE(PG8_SB(0, 0), cB, voffB); PG8_STAGE(PG8_SB(0, 1), cB + hstep, voffB); PG8_STAGE(PG8_SA(0, 0), cA, voffA); PG8_STAGE(PG8_SA(0, 1), cA + hstep, voffA);
        if (wr == 1) PG8_BAR;
        PG8_WAIT_V(2); PG8_BAR;
        PG8_STAGE(PG8_SB(1, 0), cB + kstep, voffB); PG8_STAGE(PG8_SA(1, 0), cA + kstep, voffA); PG8_STAGE(PG8_SB(1, 1), cB + hstep + kstep, voffB);
        PG8_WAIT_V(6); PG8_BAR;
    } else {
        PG8_STAGE(PG8_SB(0, 0), cB, voffB); PG8_STAGE(PG8_SA(0, 0), cA, voffA); PG8_STAGE(PG8_SB(0, 1), cB + hstep, voffB); PG8_STAGE(PG8_SA(0, 1), cA + hstep, voffA);
        if (wr == 1) PG8_BAR;
        PG8_WAIT_V(4); PG8_BAR;
        PG8_STAGE(PG8_SB(1, 0), cB + kstep, voffB); PG8_STAGE(PG8_SA(1, 0), cA + kstep, voffA); PG8_STAGE(PG8_SB(1, 1), cB + hstep + kstep, voffB);
        PG8_WAIT_V(6); PG8_BAR;
    }
    for (;;) {
        const bool has_next = S.next(ui + 1, nxt);
        const char* nA = has_next ? (const char*)g.A + (size_t)nxt.pm * tstep : cA; const char* nB = has_next ? (const char*)g.Bt + (size_t)nxt.pn * tstep : cB;
        for (int t = 0; t < nt; t += 2) {
            const bool last = (t == nt - 2);
            const char* a1 = cA + (size_t)(t + 1) * kstep;
            const char* a2 = last ? nA : cA + (size_t)(t + 2) * kstep; const char* b2 = last ? nB : cB + (size_t)(t + 2) * kstep;
            const char* a3 = a2 + kstep; const char* b3 = b2 + kstep;
            if (last && has_next) S.a_ready(nxt);
            if constexpr (SP2) {
            PG8_LDB(B0, 0, 0); PG8_LDB(B1, 0, 1); PG8_SCHED; PG8_LDA(At, 0, 0); PG8_STAGE(PG8_SA(1, 1), a1 + hstep, voffA);
            PG8_WAIT_V(8); PG8_WAIT_L(0); PG8_BAR; PG8_MMA(0, 0, At, B0); PG8_MMA(0, 1, At, B1); PG8_BAR; PG8_SCHED;
            PG8_LDA(At, 0, 1); PG8_STAGE(PG8_SB(0, 0), b2, voffB); PG8_STAGE(PG8_SB(0, 1), b2 + hstep, voffB); PG8_STAGE(PG8_SA(0, 0), a2, voffA);
            PG8_WAIT_V(8); PG8_WAIT_L(0); PG8_BAR; PG8_MMA(1, 0, At, B0); PG8_MMA(1, 1, At, B1); PG8_BAR; PG8_SCHED;
            PG8_LDB(B0, 1, 0); PG8_LDB(B1, 1, 1); PG8_SCHED; PG8_LDA(At, 1, 0); PG8_STAGE(PG8_SA(0, 1), a2 + hstep, voffA);
            PG8_WAIT_V(8); PG8_WAIT_L(0); PG8_BAR; PG8_MMA(0, 0, At, B0); PG8_MMA(0, 1, At, B1); PG8_BAR; PG8_SCHED;
            PG8_LDA(At, 1, 1); PG8_STAGE(PG8_SB(1, 0), b3, voffB); PG8_STAGE(PG8_SB(1, 1), b3 + hstep, voffB); PG8_STAGE(PG8_SA(1, 0), a3, voffA);
            PG8_WAIT_V(8); PG8_WAIT_L(0); PG8_BAR; PG8_MMA(1, 0, At, B0); PG8_MMA(1, 1, At, B1); PG8_BAR; PG8_SCHED;
            } else {
            PG8_LDB(B0, 0, 0); PG8_SCHED; PG8_LDA(At, 0, 0); PG8_STAGE(PG8_SA(1, 1), a1 + hstep, voffA);
            PG8_WAIT_L(8); PG8_BAR; PG8_WAIT_L(0); PG8_MMA(0, 0, At, B0); PG8_BAR; PG8_SCHED;
            PG8_LDB(B1, 0, 1); PG8_STAGE(PG8_SB(0, 0), b2, voffB);
            PG8_BAR; PG8_WAIT_L(0); PG8_MMA(0, 1, At, B1); PG8_BAR;
            PG8_LDA(At, 0, 1); PG8_STAGE(PG8_SA(0, 0), a2, voffA);
            PG8_BAR; PG8_WAIT_L(0); PG8_MMA(1, 0, At, B0); PG8_BAR; PG8_SCHED;
            PG8_STAGE(PG8_SB(0, 1), b2 + hstep, voffB);
            PG8_WAIT_V(6); PG8_BAR; PG8_MMA(1, 1, At, B1); PG8_BAR;
            PG8_LDB(B0, 1, 0); PG8_SCHED; PG8_LDA(At, 1, 0); PG8_STAGE(PG8_SA(0, 1), a2 + hstep, voffA);
            PG8_WAIT_L(8); PG8_BAR; PG8_WAIT_L(0); PG8_MMA(0, 0, At, B0); PG8_BAR; PG8_SCHED;
            PG8_LDB(B1, 1, 1); PG8_STAGE(PG8_SB(1, 0), b3, voffB);
            PG8_BAR; PG8_WAIT_L(0); PG8_MMA(0, 1, At, B1); PG8_BAR;
            PG8_LDA(At, 1, 1); PG8_STAGE(PG8_SA(1, 0), a3, voffA);
            PG8_BAR; PG8_WAIT_L(0); PG8_MMA(1, 0, At, B0); PG8_BAR; PG8_SCHED;
            PG8_STAGE(PG8_SB(1, 1), b3 + hstep, voffB);
            PG8_WAIT_V(6); PG8_BAR; PG8_MMA(1, 1, At, B1); PG8_BAR;
            }
        }
        if constexpr (ALIGN_EPI) { if (wr == 0) PG8_BAR; }
        if constexpr (!Epi::AFTER_DRAIN) { E(acc, cur, wr, wc, fr, fq); S.done(cur); }
        if (!has_next) break;
#pragma unroll
        for (int a = 0; a < 2; ++a)
#pragma unroll
            for (int b = 0; b < 2; ++b)
#pragma unroll
                for (int m = 0; m < 4; ++m)
#pragma unroll
                    for (int n = 0; n < 2; ++n) acc[a][b][m][n] = (f32x4){0.f, 0.f, 0.f, 0.f};
        cur = nxt; cA = nA; cB = nB; ++ui;
        if constexpr (ALIGN_EPI) { if (wr == 1) PG8_BAR; }
    }
    PG8_WAIT_V(0);
    if constexpr (!ALIGN_EPI) { if (wr == 0) PG8_BAR; }
    PG8_BAR;
    if constexpr (Epi::AFTER_DRAIN) { E.fused(acc, cur, wr, wc, fr, fq, lds, wid, lane); S.done(cur); }
#undef PG8_SA
#undef PG8_SB
#undef PG8_STAGE
#undef PG8_LDA
#undef PG8_LDB
#undef PG8_MMA
#undef PG8_WAIT_V
#undef PG8_WAIT_L
#undef PG8_BAR
#undef PG8_SCHED
}
}

#define LAS __attribute__((address_space(3)))
#define GAS __attribute__((address_space(1)))
typedef unsigned short bf16;
typedef short bf16x8 __attribute__((ext_vector_type(8)));
typedef short s16x4 __attribute__((ext_vector_type(4)));
typedef float f32x4 __attribute__((ext_vector_type(4)));
typedef float f32x2 __attribute__((ext_vector_type(2)));
typedef float f32x16 __attribute__((ext_vector_type(16)));
typedef unsigned u32x4 __attribute__((ext_vector_type(4)));
typedef unsigned u32x2 __attribute__((ext_vector_type(2)));

constexpr int T = 16384, SEQ = 4096, DM = 1024, FF = 2752, FFP = 2816, NGU = 5632, NIN = 3584, NINSRC = 3352;
constexpr int PW = 2816, FW = 544;
constexpr float EPS = 1e-6f, LOG2E = 1.4426950408889634f, NEGB = -1e30f;
constexpr int PC_Q = 0, PC_KC = 512, PC_VC = 640, PC_KS = 768, PC_VS = 896, PC_KW = 1024, PC_VW = 1152, PC_HQ = 1280, PC_HI = 1792, PC_HG = 2304;
constexpr int FC_HF = 0, FC_GATE = 512;

constexpr size_t MiB = 1u << 20;
constexpr size_t W_GU1 = 0, W_DN1 = 11 * MiB, W_IN = W_DN1 + 5 * MiB + MiB / 2, W_OUT = W_IN + 7 * MiB, W_GU2 = W_OUT + 2 * MiB, W_DN2 = W_GU2 + 11 * MiB,
                 W_C1K = W_DN2 + 5 * MiB + MiB / 2, W_C1V = W_C1K + MiB, W_C2K = W_C1V + MiB, W_C2V = W_C2K + 32768;
constexpr size_t WS_SSQ = 45 * MiB, WS_KC = 46 * MiB, WS_VC = WS_KC + 262144, WS_DC = WS_VC + 262144, WS_CB = 47 * MiB, WS_LB = WS_CB + 32768;
constexpr size_t WS_HB = 49 * MiB, WS_MIX = 81 * MiB, WS_P = 113 * MiB, WS_F = 201 * MiB, WS_QG = 235 * MiB, WS_END = 251 * MiB;
constexpr size_t WS_BAR = WS_LB + 4096;
static_assert(W_C2V + 32768 <= WS_SSQ, "weights fit");
constexpr int LDS_BYTES = 147456;

__device__ __forceinline__ unsigned pk_bf16(float lo, float hi) {
    typedef __bf16 b2 __attribute__((ext_vector_type(2)));
    f32x2 v = {lo, hi}; b2 b = __builtin_convertvector(v, b2); return __builtin_bit_cast(unsigned, b);
}
__device__ __forceinline__ float bflo(unsigned u) { return __uint_as_float(u << 16); }
__device__ __forceinline__ float bfhi(unsigned u) { return __uint_as_float(u & 0xffff0000u); }
__device__ __forceinline__ float fexp2(float x) { return __builtin_amdgcn_exp2f(x); }
__device__ __forceinline__ float fexp(float x) { return __builtin_amdgcn_exp2f(x * LOG2E); }
__device__ __forceinline__ float frcp(float x) { return __builtin_amdgcn_rcpf(x); }
__device__ __forceinline__ float sigmoidf_(float x) { return frcp(1.0f + fexp(-x)); }
__device__ __forceinline__ float siluf_(float x) { return x * sigmoidf_(x); }
__device__ __forceinline__ float gelu_tanh(float x) { const float u = 0.7978845608028654f * (x + 0.044715f * x * x * x); return x * sigmoidf_(2.0f * u); }
__device__ __forceinline__ float wave_sum(float v) {
#pragma unroll
    for (int o = 1; o < 64; o <<= 1) v += __shfl_xor(v, o);
    return v;
}
__device__ __forceinline__ f32x4 mfma16(bf16x8 a, bf16x8 b, f32x4 c) { return __builtin_amdgcn_mfma_f32_16x16x32_bf16(a, b, c, 0, 0, 0); }
__device__ __forceinline__ f32x16 mfma32(bf16x8 a, bf16x8 b, f32x16 c) { return __builtin_amdgcn_mfma_f32_32x32x16_bf16(a, b, c, 0, 0, 0); }
__device__ __forceinline__ float rstd_from(const f32x4 a) { return 1.0f / sqrtf(((a[0] + a[1]) + (a[2] + a[3])) * (1.0f / DM) + EPS); }
__device__ __forceinline__ float rstd_of(const GAS float* ssq, int row) { return rstd_from(*(const GAS f32x4*)(ssq + (unsigned)(row * 4))); }

namespace pg8 {
struct EpiGU {
    static constexpr bool PERM = true, AFTER_DRAIN = false;
    GAS bf16_t* act; const GAS float* ssq;
    __device__ __forceinline__ void operator()(const f32x4 (&acc)[2][2][4][2], const Unit& u, int wr, int wc, int fr, int fq) const {
        int row0 = u.pm * BM + wr * 64 + fr; asm volatile("" : "+v"(row0)); const int col = u.pn * 128 + wc * 32 + 8 * fq;
        float rsv[2][4];
#pragma unroll
        for (int ai = 0; ai < 2; ++ai)
#pragma unroll
            for (int m = 0; m < 4; ++m) rsv[ai][m] = rstd_of(ssq, row0 + ai * HALF + m * 16);
#pragma unroll
        for (int ai = 0; ai < 2; ++ai)
#pragma unroll
            for (int m = 0; m < 4; ++m) {
                const int row = row0 + ai * HALF + m * 16; const float rs = rsv[ai][m];
                float a[8];
#pragma unroll
                for (int n = 0; n < 2; ++n)
#pragma unroll
                    for (int i = 0; i < 4; ++i) { const float g = acc[ai][0][m][n][i] * rs, up = acc[ai][1][m][n][i] * rs; a[n * 4 + i] = siluf_(g) * up; }
                u32x4 w; w.x = pk_bf16(a[0], a[1]); w.y = pk_bf16(a[2], a[3]); w.z = pk_bf16(a[4], a[5]); w.w = pk_bf16(a[6], a[7]);
                *(GAS u32x4*)(act + (unsigned)(row * FFP + col)) = w;
                asm volatile("" ::: "memory");
            }
    }
};
struct EpiIN {
    static constexpr bool PERM = true, AFTER_DRAIN = false;
    GAS bf16_t* P; GAS float* F; const GAS float* ssq;
    __device__ __forceinline__ void operator()(const f32x4 (&acc)[2][2][4][2], const Unit& u, int wr, int wc, int fr, int fq) const {
        int row0 = u.pm * BM + wr * 64 + fr; asm volatile("" : "+v"(row0)); const int pn = u.pn;
        const bool isf = (pn == 7 || pn == 8 || pn == 13);
        const int pbase = (pn < 7 ? 256 * pn : 256 * (pn - 2)); const float sc = pn < 2 ? 0.125f * LOG2E : 1.0f;
        const int fbase = (pn == 13) ? 512 : 256 * (pn - 7);
        float rsv[2][4];
#pragma unroll
        for (int ai = 0; ai < 2; ++ai)
#pragma unroll
            for (int m = 0; m < 4; ++m) rsv[ai][m] = rstd_of(ssq, row0 + ai * HALF + m * 16) * sc;
#pragma unroll
        for (int ai = 0; ai < 2; ++ai)
#pragma unroll
            for (int m = 0; m < 4; ++m) {
                const int row = row0 + ai * HALF + m * 16; const float rs = rsv[ai][m];
#pragma unroll
                for (int bj = 0; bj < 2; ++bj) {
                    const int c = bj * HALF + wc * 32 + 8 * fq;
                    const f32x4 v0 = acc[ai][bj][m][0] * rs, v1 = acc[ai][bj][m][1] * rs;
                    if (isf) {
                        if (pn != 13 || c < 32) { GAS float* d = F + (unsigned)(row * FW + fbase + c); *(f32x4*)d = v0; *(GAS f32x4*)(d + 4) = v1; }
                    } else {
                        u32x4 w; w.x = pk_bf16(v0[0], v0[1]); w.y = pk_bf16(v0[2], v0[3]); w.z = pk_bf16(v1[0], v1[1]); w.w = pk_bf16(v1[2], v1[3]);
                        *(GAS u32x4*)(P + (unsigned)(row * PW + pbase + c)) = w;
                    }
                }
                asm volatile("" ::: "memory");
            }
    }
};
template <bool XSRC>
struct EpiRES {
    static constexpr bool PERM = false, AFTER_DRAIN = true;
    const GAS float* xsrc; GAS bf16_t* hb; GAS float* ssq; float alpha;
    __device__ __forceinline__ void fused(f32x4 (&acc)[2][2][4][2], const Unit& u, int wr, int wc, int fr, int fq, PG8_LAS unsigned char* lds, int wid, int lane) const {
        int row0 = u.pm * BM + wr * 64 + fr; asm volatile("" : "+v"(row0)); const int col0 = u.pn * BM + wc * 32 + 4 * fq;
        PG8_LAS float* part = (PG8_LAS float*)lds;
#pragma unroll
        for (int ai = 0; ai < 2; ++ai) {
            f32x4 pre[4][2][2];
#pragma unroll
            for (int m = 0; m < 4; ++m)
#pragma unroll
                for (int bj = 0; bj < 2; ++bj)
#pragma unroll
                    for (int n = 0; n < 2; ++n) {
                        const unsigned off = (unsigned)((row0 + ai * HALF + m * 16) * DM + col0 + bj * HALF + n * 16);
                        if (XSRC) pre[m][bj][n] = *(const GAS f32x4*)(xsrc + off);
                        else { const u32x2 w = *(const GAS u32x2*)(hb + off); pre[m][bj][n] = (f32x4){bflo(w.x), bfhi(w.x), bflo(w.y), bfhi(w.y)}; }
                    }
#pragma unroll
            for (int m = 0; m < 4; ++m) {
                const int row = row0 + ai * HALF + m * 16; float sq = 0.f;
#pragma unroll
                for (int bj = 0; bj < 2; ++bj)
#pragma unroll
                    for (int n = 0; n < 2; ++n) {
                        const unsigned off = (unsigned)(row * DM + col0 + bj * HALF + n * 16);
                        const f32x4 o = pre[m][bj][n] + acc[ai][bj][m][n] * alpha;
                        u32x2 w; w.x = pk_bf16(o[0], o[1]); w.y = pk_bf16(o[2], o[3]); *(GAS u32x2*)(hb + off) = w;
                        sq += (o[0] * o[0] + o[1] * o[1]) + (o[2] * o[2] + o[3] * o[3]);
                    }
                sq += __shfl_xor(sq, 16); sq += __shfl_xor(sq, 32);
                if (fq == 0) part[(ai * HALF + wr * 64 + m * 16 + fr) * 4 + wc] = sq;
            }
            asm volatile("" ::: "memory");
        }
        asm volatile("s_waitcnt lgkmcnt(0)" ::: "memory"); __builtin_amdgcn_s_barrier(); asm volatile("" ::: "memory");
        const int t = wid * 64 + lane;
        if (t < 256) { const f32x4 p4 = *(const PG8_LAS f32x4*)(part + t * 4); ssq[(unsigned)((u.pm * BM + t) * 4 + u.pn)] = (p4[0] + p4[1]) + (p4[2] + p4[3]); }
        asm volatile("s_waitcnt lgkmcnt(0)" ::: "memory"); __builtin_amdgcn_s_barrier(); asm volatile("" ::: "memory");
    }
};
}

__device__ __forceinline__ int map_col(int mode, int n, int N) {
    if (mode == 0) return n < N ? n : -1;
    if (mode == 1) { const int t = n >> 8, r = n & 255, c = 128 * t + (r & 127); return c < FF ? (r < 128 ? c : FF + c) : -1; }
    if (n < 1280) return n;
    if (n < 3328) return n + 24;
    if (n < 3352) return 1280 + (n - 3328);
    return -1;
}
__device__ __forceinline__ void conv_item(const GAS float* W, int K, int N, const GAS float* gain, GAS bf16* WT, int KP, int mode, LAS float* scr, int item, int lane) {
    const int kblks = KP >> 6, nb = item / kblks, kb = item - nb * kblks, k0 = 64 * kb, n0 = 64 * nb;
    const int l16 = lane & 15, kq = lane >> 4;
    const int src = map_col(mode, n0 + 4 * l16, N);
    f32x4 v[16];
#pragma unroll
    for (int i = 0; i < 16; ++i) {
        const int k = k0 + 4 * i + kq;
        v[i] = (f32x4){0.f, 0.f, 0.f, 0.f};
        if (src >= 0 && k < K) { v[i] = *(const GAS f32x4*)(W + (size_t)k * N + src); if (gain) v[i] = v[i] * gain[k]; }
    }
#pragma unroll
    for (int i = 0; i < 16; ++i) {
        LAS float* d = scr + (4 * i + kq) * 65 + 4 * l16;
        d[0] = v[i][0]; d[1] = v[i][1]; d[2] = v[i][2]; d[3] = v[i][3];
    }
    asm volatile("s_waitcnt lgkmcnt(0)" ::: "memory");
    const int c = lane & 7;
#pragma unroll
    for (int j = 0; j < 8; ++j) {
        const int n = (lane >> 3) + 8 * j; const LAS float* s = scr + (8 * c) * 65 + n;
        u32x4 o; o.x = pk_bf16(s[0 * 65], s[1 * 65]); o.y = pk_bf16(s[2 * 65], s[3 * 65]); o.z = pk_bf16(s[4 * 65], s[5 * 65]); o.w = pk_bf16(s[6 * 65], s[7 * 65]);
        *(GAS u32x4*)(WT + (size_t)(n0 + n) * KP + k0 + 8 * c) = o;
    }
    asm volatile("s_waitcnt lgkmcnt(0)" ::: "memory");
}

struct Args { const GAS float* in[19]; GAS float* out; GAS unsigned char* ws; int ph_lo, ph_hi; };

__device__ __forceinline__ void prologue(const Args& A, GAS unsigned char* ws, int layer, LAS unsigned char* lds, int tid, int wave, int lane) {
    LAS float* scr = (LAS float*)(lds + wave * 16640);
    const int gw = blockIdx.x * 8 + wave, NGW = gridDim.x * 8;
    constexpr int I_GU = (NGU / 64) * (DM / 64), I_DN = (DM / 64) * (FFP / 64), I_IN = (NIN / 64) * (DM / 64), I_OUT = (DM / 64) * (DM / 64), I_C1 = (256 / 64) * (2048 / 64), I_C2 = (64 / 64) * (256 / 64);
    constexpr int NITEMS = 2 * I_GU + 2 * I_DN + I_IN + I_OUT + 2 * I_C1 + 2 * I_C2;
    const size_t lgu = (size_t)layer * DM * 2 * FF, ldn = (size_t)layer * FF * DM;
    for (int it = gw; it < NITEMS; it += NGW) {
        int r = it;
        if (r < I_GU) { conv_item(A.in[2] + lgu, DM, 2 * FF, A.in[1] + layer * DM, (GAS bf16*)(ws + W_GU1), DM, 1, scr, r, lane); continue; } r -= I_GU;
        if (r < I_GU) { conv_item(A.in[16] + lgu, DM, 2 * FF, A.in[15] + layer * DM, (GAS bf16*)(ws + W_GU2), DM, 1, scr, r, lane); continue; } r -= I_GU;
        if (r < I_DN) { conv_item(A.in[3] + ldn, FF, DM, nullptr, (GAS bf16*)(ws + W_DN1), FFP, 0, scr, r, lane); continue; } r -= I_DN;
        if (r < I_DN) { conv_item(A.in[17] + ldn, FF, DM, nullptr, (GAS bf16*)(ws + W_DN2), FFP, 0, scr, r, lane); continue; } r -= I_DN;
        if (r < I_IN) { conv_item(A.in[5] + (size_t)layer * DM * NINSRC, DM, NINSRC, A.in[4] + layer * DM, (GAS bf16*)(ws + W_IN), DM, 2, scr, r, lane); continue; } r -= I_IN;
        if (r < I_OUT) { conv_item(A.in[14] + (size_t)layer * DM * DM, DM, DM, nullptr, (GAS bf16*)(ws + W_OUT), DM, 0, scr, r, lane); continue; } r -= I_OUT;
        if (r < I_C1) { conv_item(A.in[8] + (size_t)layer * 2048 * 256, 2048, 256, nullptr, (GAS bf16*)(ws + W_C1K), 2048, 0, scr, r, lane); continue; } r -= I_C1;
        if (r < I_C1) { conv_item(A.in[10] + (size_t)layer * 2048 * 256, 2048, 256, nullptr, (GAS bf16*)(ws + W_C1V), 2048, 0, scr, r, lane); continue; } r -= I_C1;
        if (r < I_C2) { conv_item(A.in[9] + (size_t)layer * 256 * 64, 256, 64, nullptr, (GAS bf16*)(ws + W_C2K), 256, 0, scr, r, lane); continue; } r -= I_C2;
        conv_item(A.in[11] + (size_t)layer * 256 * 64, 256, 64, nullptr, (GAS bf16*)(ws + W_C2V), 256, 0, scr, r, lane);
    }
    if (layer == 0) {
        GAS bf16* hb = (GAS bf16*)(ws + WS_HB); GAS float* ssq = (GAS float*)(ws + WS_SSQ); const GAS float* x = A.in[0];
        for (int row = gw; row < T; row += NGW) {
            const GAS f32x4* xr = (const GAS f32x4*)(x + (size_t)row * DM) + lane; float s = 0.f;
            GAS u32x2* o = (GAS u32x2*)(hb + (size_t)row * DM) + lane;
#pragma unroll
            for (int j = 0; j < 4; ++j) { const f32x4 v = xr[64 * j]; s += (v[0] * v[0] + v[1] * v[1]) + (v[2] * v[2] + v[3] * v[3]); u32x2 w; w.x = pk_bf16(v[0], v[1]); w.y = pk_bf16(v[2], v[3]); o[64 * j] = w; }
            s = wave_sum(s);
            if (lane < 4) ssq[(size_t)row * 4 + lane] = lane == 0 ? s : 0.f;
        }
    }
    __syncthreads();
    const int bx = (int)gridDim.x - 1 - (int)blockIdx.x;
    if (bx < 32) {
        const int kv = bx & 1, part = bx >> 1;
        const GAS float* pos = A.in[kv == 0 ? 6 : 7] + (size_t)layer * 2048; const GAS float* w1 = A.in[kv == 0 ? 8 : 10] + (size_t)layer * 2048 * 256;
        const int n = tid & 255, half = tid >> 8; float s = 0.f;
        const int j0 = part * 128 + half * 64;
#pragma unroll 16
        for (int j = j0; j < j0 + 64; ++j) s += pos[j] * w1[(size_t)j * 256 + n];
        LAS float* red = (LAS float*)(lds + 8 * 16640);
        if (half) red[n] = s;
        __syncthreads();
        if (!half) ((GAS float*)(ws + WS_CB))[(part * 2 + kv) * 256 + n] = s + red[n];
    } else if (bx == 32) {
        const GAS float* lbp = A.in[12]; float v = 0.f;
        if (layer == 1) { const float a0 = lbp[tid], a1 = lbp[512 + tid]; v = 1.0f / (1.0f + expf(a0 - a1)); }
        ((GAS float*)(ws + WS_LB))[tid] = v;
    }
}

__device__ __forceinline__ void compress_item(GAS unsigned char* ws, int ci, LAS unsigned char* lds, int tid, int wave, int lane) {
    asm volatile("" : "+v"(tid)); lane = tid & 63;
    const int kv = ci >> 7, r0 = (ci & 127) * 16, rr = lane & 15, quad = lane >> 4;
    const GAS bf16* P = (const GAS bf16*)(ws + WS_P); const GAS bf16* w1t = (const GAS bf16*)(ws + (kv ? W_C1V : W_C1K)); const GAS bf16* w2t = (const GAS bf16*)(ws + (kv ? W_C2V : W_C2K));
    const GAS float* cb = (const GAS float*)(ws + WS_CB) + kv * 256;
    LAS bf16* HID = (LAS bf16*)lds;
    const int r = r0 + rr, rb = r >> 9, rnb = (r >> 1) & 255, rg = r & 1;
    const GAS bf16* ap = P + (size_t)(rb * SEQ + rnb * 16) * PW + PC_KC + kv * 128 + rg * 64 + 8 * quad;
    const GAS bf16* bp[2];
#pragma unroll
    for (int j = 0; j < 2; ++j) bp[j] = w1t + (size_t)(32 * wave + 16 * j + rr) * 2048 + 8 * quad;
    const int tokbase = rb * SEQ + rnb * 16;
    f32x4 acc[2];
#pragma unroll
    for (int j = 0; j < 2; ++j) acc[j] = (f32x4){0.f, 0.f, 0.f, 0.f};
    __syncthreads();
#pragma unroll 8
    for (int ks = 0; ks < 64; ++ks) {
        const int l = ks >> 1, dd = 32 * (ks & 1);
        const int tok = tokbase + l; const int back = tok > T - 1 ? tok - (T - 1) : 0;
        const bf16x8 a = *(const GAS bf16x8*)(ap + (size_t)l * PW + dd - (size_t)back * PW);
        bf16x8 b[2];
#pragma unroll
        for (int j = 0; j < 2; ++j) b[j] = *(const GAS bf16x8*)(bp[j] + 32 * ks);
#pragma unroll
        for (int j = 0; j < 2; ++j) acc[j] = mfma16(a, b[j], acc[j]);
    }
#pragma unroll
    for (int j = 0; j < 2; ++j) {
        const int n = 32 * wave + 16 * j + rr; float bias = 0.f;
#pragma unroll
        for (int pp = 0; pp < 16; ++pp) bias += cb[pp * 512 + n];
#pragma unroll
        for (int e = 0; e < 4; ++e) { const int row = 4 * quad + e; HID[row * 264 + n] = (bf16)(pk_bf16(gelu_tanh(acc[j][e] + bias), 0.f) & 0xffffu); }
    }
    __syncthreads();
    if (wave < 4) {
        const int cti = wave; f32x4 o = (f32x4){0.f, 0.f, 0.f, 0.f};
#pragma unroll
        for (int ks = 0; ks < 8; ++ks) {
            const bf16x8 a = *(const LAS bf16x8*)(HID + rr * 264 + 32 * ks + 8 * quad);
            const bf16x8 b = *(const GAS bf16x8*)(w2t + (size_t)(16 * cti + rr) * 256 + 32 * ks + 8 * quad);
            o = mfma16(a, b, o);
        }
        GAS bf16* dst = (GAS bf16*)(ws + (kv ? WS_VC : WS_KC));
#pragma unroll
        for (int e = 0; e < 4; ++e) {
            const int r2 = r0 + 4 * quad + e, b2 = r2 >> 9, nb2 = (r2 >> 1) & 255, g2 = r2 & 1;
            dst[((size_t)(b2 * 2 + g2) * 256 + nb2) * 64 + 16 * cti + rr] = nb2 == 255 ? (bf16)0 : (bf16)(pk_bf16(o[e], 0.f) & 0xffffu);
        }
    }
}

__device__ __forceinline__ void hg_step1(GAS unsigned char* ws, GAS bf16* S, int item, LAS unsigned char* lds, int tid, int wave, int lane) {
    asm volatile("" : "+v"(tid)); lane = tid & 63;
    const int ch = item & 63, bh = item >> 6, h = bh & 3, b = bh >> 2, tok0 = b * SEQ + ch * 64;
    GAS bf16* P = (GAS bf16*)(ws + WS_P); const GAS float* F = (const GAS float*)(ws + WS_F); GAS bf16* MIX = (GAS bf16*)(ws + WS_MIX);
    GAS float* DC = (GAS float*)(ws + WS_DC); const GAS float* LB = (const GAS float*)(ws + WS_LB);
    LAS float* Bc = (LAS float*)lds;
    LAS float* TOT = (LAS float*)(lds + 33792);
    LAS bf16* Qh = (LAS bf16*)(lds + 35840);
    LAS bf16* Kh = (LAS bf16*)(lds + 53248);
    LAS bf16* KgT = (LAS bf16*)(lds + 70656);
    LAS bf16* VT = (LAS bf16*)(lds + 89088);
    LAS bf16* Am = (LAS bf16*)(lds + 107520);
    const int rr = lane & 15, quad = lane >> 4;
    __syncthreads();
#pragma unroll
    for (int i = 0; i < 4; ++i) {
        const int qi = tid + 512 * i, t = qi >> 5, d = (qi & 31) * 4;
        const f32x4 z = *(const GAS f32x4*)(F + (size_t)(tok0 + t) * FW + FC_HF + h * 128 + d);
        const f32x4 lb = *(const GAS f32x4*)(LB + h * 128 + d);
        f32x4 lf;
#pragma unroll
        for (int e = 0; e < 4; ++e) { const float f = lb[e] + (1.0f - lb[e]) * sigmoidf_(z[e]); lf[e] = __logf(fmaxf(f, 1e-30f)); }
        *(LAS f32x4*)(Bc + t * 132 + d) = lf;
    }
    __syncthreads();
    {
        const int d = tid & 127, part = tid >> 7; float run = 0.f;
#pragma unroll
        for (int t = 0; t < 16; ++t) { run += Bc[(16 * part + t) * 132 + d]; Bc[(16 * part + t) * 132 + d] = run; }
        TOT[part * 128 + d] = run;
        __syncthreads();
        float off = 0.f;
        for (int p = 0; p < part; ++p) off += TOT[p * 128 + d];
        if (part > 0) {
#pragma unroll
            for (int t = 0; t < 16; ++t) Bc[(16 * part + t) * 132 + d] += off;
        }
    }
    __syncthreads();
#pragma unroll
    for (int i = 0; i < 4; ++i) {
        const int qi = tid + 512 * i, t = qi >> 5, d = (qi & 31) * 4;
        const f32x4 z = *(const GAS f32x4*)(F + (size_t)(tok0 + t) * FW + FC_HF + h * 128 + d);
        const f32x4 lb = *(const GAS f32x4*)(LB + h * 128 + d);
        GAS bf16* prow = P + (size_t)(tok0 + t) * PW + h * 128 + d;
        const u32x2 hq = *(const GAS u32x2*)(prow + PC_HQ), hi = *(const GAS u32x2*)(prow + PC_HI);
        const f32x4 bb = *(const LAS f32x4*)(Bc + t * 132 + d), mm = *(const LAS f32x4*)(Bc + 31 * 132 + d), bl = *(const LAS f32x4*)(Bc + 63 * 132 + d);
        const float qv[4] = {bflo(hq.x), bfhi(hq.x), bflo(hq.y), bfhi(hq.y)};
        float qh[4], kh[4], qg[4], kg[4];
#pragma unroll
        for (int e = 0; e < 4; ++e) {
            const float qs = siluf_(qv[e]), kf = (1.0f - lb[e]) * sigmoidf_(-z[e]);
            qh[e] = qs * fexp(bb[e] - mm[e]); kh[e] = kf * fexp(mm[e] - bb[e]); qg[e] = qs * fexp(bb[e]); kg[e] = kf * fexp(bl[e] - bb[e]);
        }
        u32x2 w; w.x = pk_bf16(qh[0], qh[1]); w.y = pk_bf16(qh[2], qh[3]); *(LAS u32x2*)(Qh + t * 136 + d) = w;
        w.x = pk_bf16(kh[0], kh[1]); w.y = pk_bf16(kh[2], kh[3]); *(LAS u32x2*)(Kh + t * 136 + d) = w;
        w.x = pk_bf16(qg[0], qg[1]); w.y = pk_bf16(qg[2], qg[3]); *(GAS u32x2*)((GAS bf16*)(ws + WS_QG) + (size_t)(tok0 + t) * 512 + h * 128 + d) = w;
        const unsigned k01 = pk_bf16(kg[0], kg[1]), k23 = pk_bf16(kg[2], kg[3]);
        KgT[(d + 0) * 72 + t] = (bf16)(k01 & 0xffffu); KgT[(d + 1) * 72 + t] = (bf16)(k01 >> 16); KgT[(d + 2) * 72 + t] = (bf16)(k23 & 0xffffu); KgT[(d + 3) * 72 + t] = (bf16)(k23 >> 16);
        VT[(d + 0) * 72 + t] = (bf16)(hi.x & 0xffffu); VT[(d + 1) * 72 + t] = (bf16)(hi.x >> 16); VT[(d + 2) * 72 + t] = (bf16)(hi.y & 0xffffu); VT[(d + 3) * 72 + t] = (bf16)(hi.y >> 16);
        if (t == 63) { f32x4 dcv;
#pragma unroll
            for (int e = 0; e < 4; ++e) dcv[e] = fexp(bl[e]);
            *(GAS f32x4*)(DC + (size_t)item * 128 + d) = dcv; }
    }
    __syncthreads();
    {
        const int ti = wave >> 1;
#pragma unroll
        for (int q = 0; q < 2; ++q) {
            const int si = (wave & 1) * 2 + q; f32x4 acc = (f32x4){0.f, 0.f, 0.f, 0.f};
            if (si <= ti) {
#pragma unroll
                for (int ks = 0; ks < 4; ++ks) {
                    const bf16x8 a = *(const LAS bf16x8*)(Qh + (16 * ti + rr) * 136 + 32 * ks + 8 * quad);
                    const bf16x8 bq = *(const LAS bf16x8*)(Kh + (16 * si + rr) * 136 + 32 * ks + 8 * quad);
                    acc = mfma16(a, bq, acc);
                }
            }
#pragma unroll
            for (int e = 0; e < 4; ++e) { const int t = 16 * ti + 4 * quad + e, s = 16 * si + rr; const float v = (s <= t) ? acc[e] : 0.f; Am[t * 72 + s] = (bf16)(pk_bf16(v, 0.f) & 0xffffu); }
        }
    }
    __syncthreads();
    {
        const int ti = wave & 3;
#pragma unroll
        for (int q = 0; q < 4; ++q) {
            const int vi = (wave >> 2) * 4 + q; f32x4 acc = (f32x4){0.f, 0.f, 0.f, 0.f};
#pragma unroll
            for (int ks = 0; ks < 2; ++ks) {
                const bf16x8 a = *(const LAS bf16x8*)(VT + (16 * vi + rr) * 72 + 32 * ks + 8 * quad);
                const bf16x8 bq = *(const LAS bf16x8*)(Am + (16 * ti + rr) * 72 + 32 * ks + 8 * quad);
                acc = mfma16(a, bq, acc);
            }
            u32x2 w; w.x = pk_bf16(acc[0], acc[1]); w.y = pk_bf16(acc[2], acc[3]);
            *(GAS u32x2*)(MIX + (size_t)(tok0 + 16 * ti + rr) * DM + 512 + h * 128 + 16 * vi + 4 * quad) = w;
        }
#pragma unroll
        for (int vi = 0; vi < 8; ++vi) {
            f32x4 acc = (f32x4){0.f, 0.f, 0.f, 0.f};
#pragma unroll
            for (int ks = 0; ks < 2; ++ks) {
                const bf16x8 a = *(const LAS bf16x8*)(KgT + (16 * wave + rr) * 72 + 32 * ks + 8 * quad);
                const bf16x8 bq = *(const LAS bf16x8*)(VT + (16 * vi + rr) * 72 + 32 * ks + 8 * quad);
                acc = mfma16(a, bq, acc);
            }
            u32x2 w; w.x = pk_bf16(acc[0], acc[1]); w.y = pk_bf16(acc[2], acc[3]);
            *(GAS u32x2*)(S + (size_t)item * 16384 + (16 * vi + rr) * 128 + 16 * wave + 4 * quad) = w;
        }
    }
}
__device__ __forceinline__ void hg_scan(GAS unsigned char* ws, GAS bf16* S, int tid, bool dummy = false) {
    const GAS float* DC = (const GAS float*)(ws + WS_DC);
    for (int gt = blockIdx.x * 512 + tid; gt < 131072; gt += gridDim.x * 512) {
        const int bh = gt >> 13, e = (gt & 8191) * 2, d = e & 127;
        float s0 = 0.f, s1 = 0.f;
        GAS unsigned* p = (GAS unsigned*)(S + (size_t)bh * 64 * 16384 + e); const GAS float* dc = DC + (size_t)bh * 64 * 128 + d;
        unsigned sv[16]; f32x2 dv[16];
#pragma unroll
        for (int j = 0; j < 16; ++j) { sv[j] = p[(size_t)j * 8192]; dv[j] = *(const GAS f32x2*)(dc + j * 128); }
#pragma unroll 1
        for (int cb = 0; cb < 4; ++cb) {
            unsigned nsv[16]; f32x2 ndv[16];
            if (cb < 3) {
#pragma unroll
                for (int j = 0; j < 16; ++j) { nsv[j] = p[(size_t)(16 * cb + 16 + j) * 8192]; ndv[j] = *(const GAS f32x2*)(dc + (16 * cb + 16 + j) * 128); }
            }
#pragma unroll
            for (int j = 0; j < 16; ++j) {
                if (!dummy || s0 == 12345.678f) p[(size_t)(16 * cb + j) * 8192] = pk_bf16(s0, s1);
                s0 = dv[j][0] * s0 + bflo(sv[j]); s1 = dv[j][1] * s1 + bfhi(sv[j]);
            }
            if (cb < 3) {
#pragma unroll
                for (int j = 0; j < 16; ++j) { sv[j] = nsv[j]; dv[j] = ndv[j]; }
            }
        }
    }
}
__device__ __forceinline__ void hg_step3(GAS unsigned char* ws, const GAS bf16* Sb, const GAS float* onorm, int item, LAS unsigned char* lds, int tid, int wave, int lane, bool scratch_out = false) {
    asm volatile("" : "+v"(tid)); lane = tid & 63;
    const int ch = item & 63, bh = item >> 6, h = bh & 3, b = bh >> 2, tok0 = b * SEQ + ch * 64;
    const GAS bf16* P = (const GAS bf16*)(ws + WS_P); GAS bf16* MIX = (GAS bf16*)(ws + WS_MIX); const GAS bf16* S = Sb + (size_t)item * 16384;
    LAS float* red = (LAS float*)lds;
    const int rr = lane & 15, quad = lane >> 4, ti = wave & 3, vh = wave >> 2, t = 16 * ti + rr, tok = tok0 + t;
    bf16x8 bq[4];
#pragma unroll
    for (int ks = 0; ks < 4; ++ks) bq[ks] = *(const GAS bf16x8*)((const GAS bf16*)(ws + WS_QG) + (size_t)tok * 512 + h * 128 + 32 * ks + 8 * quad);
    f32x4 o[4]; float sq = 0.f;
#pragma unroll
    for (int q = 0; q < 4; ++q) {
        const int vi = 4 * vh + q; f32x4 acc = (f32x4){0.f, 0.f, 0.f, 0.f};
#pragma unroll
        for (int ks = 0; ks < 4; ++ks) { const bf16x8 a = *(const GAS bf16x8*)(S + (16 * vi + rr) * 128 + 32 * ks + 8 * quad); acc = mfma16(a, bq[ks], acc); }
        const u32x2 oi = *(const GAS u32x2*)(MIX + (size_t)tok * DM + 512 + h * 128 + 16 * vi + 4 * quad);
        acc[0] += bflo(oi.x); acc[1] += bfhi(oi.x); acc[2] += bflo(oi.y); acc[3] += bfhi(oi.y);
        o[q] = acc; sq += (acc[0] * acc[0] + acc[1] * acc[1]) + (acc[2] * acc[2] + acc[3] * acc[3]);
    }
    sq += __shfl_xor(sq, 16); sq += __shfl_xor(sq, 32);
    __syncthreads();
    if (quad == 0) red[vh * 64 + t] = sq;
    __syncthreads();
    const float rs = 1.0f / sqrtf((red[t] + red[64 + t]) * (1.0f / 128.0f) + EPS);
#pragma unroll
    for (int q = 0; q < 4; ++q) {
        const int v = 16 * (4 * vh + q) + 4 * quad;
        const f32x4 on = *(const GAS f32x4*)(onorm + v);
        const u32x2 g = *(const GAS u32x2*)(P + (size_t)tok * PW + PC_HG + h * 128 + v);
        const float r0 = o[q][0] * rs * on[0] * siluf_(bflo(g.x)), r1 = o[q][1] * rs * on[1] * siluf_(bfhi(g.x)), r2 = o[q][2] * rs * on[2] * siluf_(bflo(g.y)), r3 = o[q][3] * rs * on[3] * siluf_(bfhi(g.y));
        u32x2 w; w.x = pk_bf16(r0, r1); w.y = pk_bf16(r2, r3);
        if (scratch_out) *(GAS u32x2*)((GAS bf16*)(ws + WS_F) + (size_t)tok * (FW * 2) + h * 128 + v) = w;
        else *(GAS u32x2*)(MIX + (size_t)tok * DM + 512 + h * 128 + v) = w;
    }
}

template <int MODE>
__device__ __forceinline__ void nsa_scores(f32x16& p0, f32x16& p1, const LAS unsigned char* Kt, const LAS unsigned char* qptr, int lane, float base, float sl2) {
    constexpr float STR = (MODE == 0) ? 16.f : 1.f;
    bf16x8 qf[4];
#pragma unroll
    for (int ks = 0; ks < 4; ++ks) qf[ks] = *(const LAS bf16x8*)(qptr + 1024 * ks);
    const LAS unsigned char* kb = Kt + (lane & 31) * 144 + (lane >> 5) * 16;
    const float b1 = base + sl2 * (32.f * STR);
#pragma unroll
    for (int r = 0; r < 16; ++r) { const float c = (float)((r & 3) + 8 * (r >> 2)) * STR; p0[r] = sl2 * c + base; p1[r] = sl2 * c + b1; }
    __builtin_amdgcn_s_setprio(1);
#pragma unroll
    for (int ks = 0; ks < 4; ++ks) {
        const bf16x8 a0 = *(const LAS bf16x8*)(kb + ks * 32), a1 = *(const LAS bf16x8*)(kb + 32 * 144 + ks * 32);
        p0 = mfma32(a0, qf[ks], p0); p1 = mfma32(a1, qf[ks], p1);
    }
    __builtin_amdgcn_s_setprio(0);
}
template <int MODE>
__device__ __forceinline__ void nsa_mask(f32x16& p0, f32x16& p1, float d0) {
    constexpr float STR = (MODE == 0) ? 16.f : 1.f;
#pragma unroll
    for (int r = 0; r < 16; ++r) {
        const float c0 = (float)((r & 3) + 8 * (r >> 2)) * STR, c1 = c0 + 32.f * STR;
        bool v0 = d0 >= c0, v1 = d0 >= c1;
        if (MODE == 2) { v0 = v0 && (d0 - c0) < 512.f; v1 = v1 && (d0 - c1) < 512.f; }
        p0[r] = v0 ? p0[r] : -INFINITY; p1[r] = v1 ? p1[r] : -INFINITY;
    }
}
__device__ __forceinline__ float max3f_(float a, float b, float c) { float r; asm("v_max3_f32 %0, %1, %2, %3" : "=v"(r) : "v"(a), "v"(b), "v"(c)); return r; }
typedef short v4i16_t __attribute__((ext_vector_type(4)));
__device__ __forceinline__ s16x4 vtr(const LAS unsigned char* p) { return __builtin_bit_cast(s16x4, __builtin_amdgcn_ds_read_tr16_b64_v4i16((LAS v4i16_t*)p)); }
__device__ __forceinline__ void nsa_softmax_pv(f32x16& p0, f32x16& p1, const LAS unsigned char* Vt, float& m, float& l, f32x16 (&oT)[2], int lane) {
    float mx = max3f_(p0[0], p1[0], p0[1]), mx2 = max3f_(p1[1], p0[2], p1[2]);
#pragma unroll
    for (int r = 3; r < 15; r += 2) { mx = max3f_(mx, p0[r], p1[r]); mx2 = max3f_(mx2, p0[r + 1], p1[r + 1]); }
    mx = max3f_(mx, p0[15], p1[15]);
    mx = max3f_(mx, mx2, __shfl_xor(mx, 32));
    mx = max3f_(mx, mx, __shfl_xor(mx2, 32));
    const float mn = max3f_(m, mx, mx);
    if (__any(mn != m)) {
        const float alpha = fexp2(m - mn); l *= alpha;
#pragma unroll
        for (int r = 0; r < 16; ++r) { oT[0][r] *= alpha; oT[1][r] *= alpha; }
        m = mn;
    }
    float ps = 0.f;
#pragma unroll
    for (int r = 0; r < 16; ++r) { p0[r] = fexp2(p0[r] - mn); p1[r] = fexp2(p1[r] - mn); ps += p0[r] + p1[r]; }
    l += ps;
    const LAS unsigned char* vb = Vt + (4 * (lane >> 5) + ((lane & 15) >> 2)) * 144 + (16 * ((lane >> 4) & 1) + 4 * (lane & 3)) * 2;
#pragma unroll
    for (int s = 0; s < 4; ++s) {
        bf16x8 bp;
        {
            const f32x16& pp = (s < 2) ? p0 : p1; const int o = 8 * (s & 1);
            const unsigned w0 = pk_bf16(pp[o + 0], pp[o + 1]), w1 = pk_bf16(pp[o + 2], pp[o + 3]), w2 = pk_bf16(pp[o + 4], pp[o + 5]), w3 = pk_bf16(pp[o + 6], pp[o + 7]);
            const u32x4 wv = {w0, w1, w2, w3}; bp = __builtin_bit_cast(bf16x8, wv);
        }
#pragma unroll
        for (int dt = 0; dt < 2; ++dt) {
            const s16x4 lo = vtr(vb + (16 * s) * 144 + dt * 64), hi8 = vtr(vb + (16 * s + 8) * 144 + dt * 64);
            const bf16x8 av = {lo[0], lo[1], lo[2], lo[3], hi8[0], hi8[1], hi8[2], hi8[3]};
            oT[dt] = mfma32(av, bp, oT[dt]);
        }
    }
}

__device__ __forceinline__ void nsa_load_kv(const GAS bf16* P, int tokb, int kcol, int vcol, int tid, u32x4& kr, u32x4& vr) {
    const int row = tid >> 3, ch = tid & 7; const GAS bf16* p = P + (size_t)(tokb + row) * PW + ch * 8;
    kr = *(const GAS u32x4*)(p + kcol); vr = *(const GAS u32x4*)(p + vcol);
}
__device__ __forceinline__ void nsa_store_kv(LAS unsigned char* Kt, LAS unsigned char* Vt, int tid, const u32x4& kr, const u32x4& vr) {
    const int row = tid >> 3, ch = tid & 7;
    *(LAS u32x4*)(Kt + row * 144 + ch * 16) = kr;
    *(LAS u32x4*)(Vt + row * 144 + ch * 16) = vr;
}

template <int MODE>
__device__ __forceinline__ void nsa_step(const LAS unsigned char* qf, int jc, int qt, int qpos, float sl2, unsigned long long mymask, LAS unsigned char* Kt, LAS unsigned char* Vt, int lane, float& m, float& l, f32x16 (&oT)[2]) {
    f32x16 p0, p1;
    const float d0 = (float)(qpos - 64 * jc - 4 * (lane >> 5));
    const bool ok = (MODE == 2) || ((mymask >> jc) & 1ull);
    if (MODE == 2 || __any(ok)) {
        nsa_scores<MODE>(p0, p1, Kt, qf, lane, ok ? -sl2 * d0 : -INFINITY, sl2);
        if (jc == qt || (MODE == 2 && jc == qt - 8)) nsa_mask<MODE>(p0, p1, d0);
        nsa_softmax_pv(p0, p1, Vt, m, l, oT, lane);
    }
}
template <int MODE>
__device__ __forceinline__ void nsa_branch(const GAS bf16* P, unsigned long long blocks, int b, int g, int qt, int qpos, float sl2, unsigned long long mymask, const LAS unsigned char* qf,
                                           LAS unsigned char* lds, int tid, int lane, float& m, float& l, f32x16 (&oT)[2]) {
    const int kcol = (MODE == 1 ? PC_KS : PC_KW) + g * 64, vcol = (MODE == 1 ? PC_VS : PC_VW) + g * 64;
    u32x4 ka, va, kb, vb;
    int j0 = -1, j1 = -1;
    if (blocks) { j0 = __builtin_ctzll(blocks); blocks &= blocks - 1; nsa_load_kv(P, b * SEQ + 64 * j0, kcol, vcol, tid, ka, va); }
    if (blocks) { j1 = __builtin_ctzll(blocks); blocks &= blocks - 1; nsa_load_kv(P, b * SEQ + 64 * j1, kcol, vcol, tid, kb, vb); }
    LAS unsigned char* K0 = lds; LAS unsigned char* V0 = lds + 9216; LAS unsigned char* K1 = lds + 18432; LAS unsigned char* V1 = lds + 27648;
    while (j0 >= 0) {
        nsa_store_kv(K0, V0, tid, ka, va);
        const int jc0 = j0; j0 = -1;
        if (blocks) { j0 = __builtin_ctzll(blocks); blocks &= blocks - 1; nsa_load_kv(P, b * SEQ + 64 * j0, kcol, vcol, tid, ka, va); }
        __syncthreads();
        nsa_step<MODE>(qf, jc0, qt, qpos, sl2, mymask, K0, V0, lane, m, l, oT);
        if (j1 < 0) break;
        nsa_store_kv(K1, V1, tid, kb, vb);
        const int jc1 = j1; j1 = -1;
        if (blocks) { j1 = __builtin_ctzll(blocks); blocks &= blocks - 1; nsa_load_kv(P, b * SEQ + 64 * j1, kcol, vcol, tid, kb, vb); }
        __syncthreads();
        nsa_step<MODE>(qf, jc1, qt, qpos, sl2, mymask, K1, V1, lane, m, l, oT);
    }
}

__device__ __forceinline__ void nsa_tile(GAS unsigned char* ws, int b, int g, int qt, LAS unsigned char* lds, int tid, int wave, int lane) {
    asm volatile("" : "+v"(tid)); lane = tid & 63;
    const GAS bf16* P = (const GAS bf16*)(ws + WS_P); const GAS float* F = (const GAS float*)(ws + WS_F); GAS bf16* MIX = (GAS bf16*)(ws + WS_MIX);
    const int hh = wave & 3, head = g * 4 + hh, s0 = qt * 64, qpos = s0 + (wave >> 2) * 32 + (lane & 31), tok = b * SEQ + qpos, hi = lane >> 5;
    const float sl2 = exp2f(-(float)(head + 1)) * LOG2E;
    LAS unsigned char* KC = lds; LAS unsigned char* VCT = lds + 36864;
    LAS unsigned* PSLC = (LAS unsigned*)(lds + 73728); LAS unsigned long long* SELM = (LAS unsigned long long*)(lds + 90624); LAS unsigned long long* UM = (LAS unsigned long long*)(lds + 91136);
    __syncthreads();
    {
        const GAS bf16* kc = (const GAS bf16*)(ws + WS_KC) + (size_t)(b * 2 + g) * 256 * 64; const GAS bf16* vc = (const GAS bf16*)(ws + WS_VC) + (size_t)(b * 2 + g) * 256 * 64;
#pragma unroll
        for (int i = 0; i < 4; ++i) {
            const int ci = tid + 512 * i, row = ci >> 3, ch = ci & 7;
            const u32x4 kr = *(const GAS u32x4*)(kc + row * 64 + ch * 8), vr = *(const GAS u32x4*)(vc + row * 64 + ch * 8);
            *(LAS u32x4*)(KC + row * 144 + ch * 16) = kr;
            *(LAS u32x4*)(VCT + row * 144 + ch * 16) = vr;
        }
#pragma unroll
        for (int i = 0; i < 9; ++i) if (tid + 512 * i < 64 * 65) PSLC[tid + 512 * i] = 0u;
    }
    LAS unsigned char* qf = lds + 98304 + wave * 4096 + lane * 16;
    {
        const GAS bf16* qg = P + (size_t)tok * PW + PC_Q + head * 64 + 8 * hi;
#pragma unroll
        for (int ks = 0; ks < 4; ++ks) *(LAS bf16x8*)(qf + 1024 * ks) = *(const GAS bf16x8*)(qg + 16 * ks);
    }
    const float g0 = sigmoidf_(F[(size_t)tok * FW + FC_GATE + head * 3 + 0]), g1 = sigmoidf_(F[(size_t)tok * FW + FC_GATE + head * 3 + 1]), g2 = sigmoidf_(F[(size_t)tok * FW + FC_GATE + head * 3 + 2]);
    f32x16 outa[2];
    __syncthreads();
    const int cmin = (s0 - 31) >> 4;
    const int cmax = (s0 + 32) >> 4, nblk = (cmax >> 6) + 1 > 4 ? 4 : (cmax >> 6) + 1;
    {
        float m = NEGB, l = 0.f; f32x16 oT[2];
#pragma unroll
        for (int r = 0; r < 16; ++r) { oT[0][r] = 0.f; oT[1][r] = 0.f; }
        for (int blk = 0; blk < nblk; ++blk) {
            f32x16 p0, p1;
            const float d0 = (float)(qpos - 31 - 16 * (64 * blk + 4 * hi));
            nsa_scores<0>(p0, p1, KC + blk * 64 * 144, qf, lane, -sl2 * d0, sl2);
            if (64 * blk + 63 > cmin) nsa_mask<0>(p0, p1, d0);
            nsa_softmax_pv(p0, p1, VCT + blk * 64 * 144, m, l, oT, lane);
        }
        l += __shfl_xor(l, 32);
        const float il = l > 0.f ? 1.0f / l : 0.f, sc = g0 * il;
#pragma unroll
        for (int r = 0; r < 16; ++r) { outa[0][r] = oT[0][r] * sc; outa[1][r] = oT[1][r] * sc; }
        LAS unsigned* prow = PSLC + ((wave >> 2) * 32 + (lane & 31)) * 65;
        for (int blk = 0; blk < nblk; ++blk) {
            f32x16 p0, p1;
            const float d0 = (float)(qpos - 31 - 16 * (64 * blk + 4 * hi));
            nsa_scores<0>(p0, p1, KC + blk * 64 * 144, qf, lane, -sl2 * d0, sl2);
            if (64 * blk + 63 > cmin) nsa_mask<0>(p0, p1, d0);
#pragma unroll
            for (int t2 = 0; t2 < 2; ++t2)
#pragma unroll
                for (int gq = 0; gq < 4; ++gq) {
                    const f32x16& pp = t2 ? p1 : p0; float e[4];
#pragma unroll
                    for (int i = 0; i < 4; ++i) e[i] = fexp2(pp[4 * gq + i] - m) * il;
                    const float a = 2.0f * ((e[0] + e[1]) + e[2]) + e[3], c = e[3];
                    const int jb = 16 * blk + 8 * t2 + 2 * gq + hi;
                    if (a > 0.f) atomicAdd((unsigned*)(prow + jb), (unsigned)(a * 268435456.0f + 0.5f));
                    if (c > 0.f && jb < 63) atomicAdd((unsigned*)(prow + jb + 1), (unsigned)(c * 268435456.0f + 0.5f));
                }
        }
    }
    __syncthreads();
    {
        unsigned long long um = 0ull;
        for (int qq = 0; qq < 8; ++qq) {
            const int q = wave * 8 + qq; const unsigned v = PSLC[q * 65 + lane];
            unsigned key;
            if (lane == 0 || lane == qt || lane == qt - 1) key = 0xffffffffu;
            else if (lane <= qt) key = v >= 0xfffffffdu ? 0xfffffffeu : v + 1u;
            else key = 0u;
            int rank = 0;
#pragma unroll
            for (int i = 0; i < 64; ++i) { const unsigned ki = (unsigned)__builtin_amdgcn_readlane((int)key, i); rank += (ki > key || (ki == key && i < lane)) ? 1 : 0; }
            unsigned long long sel = __ballot(rank < 16);
            sel &= (qt >= 63) ? ~0ull : ((2ull << qt) - 1ull);
            if (lane == 0) SELM[q] = sel;
            um |= sel;
        }
        if (lane == 0) UM[wave] = um;
    }
    __syncthreads();
    unsigned long long ublocks = 0ull;
#pragma unroll
    for (int i = 0; i < 8; ++i) ublocks |= UM[i];
    const unsigned long long mymask = SELM[(wave >> 2) * 32 + (lane & 31)];
    {
        float m = NEGB, l = 0.f; f32x16 oT[2];
#pragma unroll
        for (int r = 0; r < 16; ++r) { oT[0][r] = 0.f; oT[1][r] = 0.f; }
        nsa_branch<1>(P, ublocks, b, g, qt, qpos, sl2, mymask, qf, lds, tid, lane, m, l, oT);
        l += __shfl_xor(l, 32);
        const float sc = l > 0.f ? g1 / l : 0.f;
#pragma unroll
        for (int r = 0; r < 16; ++r) { outa[0][r] += oT[0][r] * sc; outa[1][r] += oT[1][r] * sc; }
    }
    __syncthreads();
    {
        float m = NEGB, l = 0.f; f32x16 oT[2];
#pragma unroll
        for (int r = 0; r < 16; ++r) { oT[0][r] = 0.f; oT[1][r] = 0.f; }
        const int jlo = qt >= 8 ? qt - 8 : 0;
        const unsigned long long upto = (qt >= 63) ? ~0ull : ((2ull << qt) - 1ull);
        const unsigned long long wblocks = upto & ~((1ull << jlo) - 1ull);
        nsa_branch<2>(P, wblocks, b, g, qt, qpos, sl2, 0ull, qf, lds, tid, lane, m, l, oT);
        l += __shfl_xor(l, 32);
        const float sc = l > 0.f ? g2 / l : 0.f;
#pragma unroll
        for (int r = 0; r < 16; ++r) { outa[0][r] += oT[0][r] * sc; outa[1][r] += oT[1][r] * sc; }
    }
#pragma unroll
    for (int dt = 0; dt < 2; ++dt)
#pragma unroll
        for (int gq = 0; gq < 4; ++gq) {
            u32x2 w; w.x = pk_bf16(outa[dt][4 * gq], outa[dt][4 * gq + 1]); w.y = pk_bf16(outa[dt][4 * gq + 2], outa[dt][4 * gq + 3]);
            *(GAS u32x2*)(MIX + (size_t)tok * DM + head * 64 + 32 * dt + 8 * gq + 4 * hi) = w;
        }
}
#define XB_TMO      128
#define XB_XCNT(j)  (256  + 64 * (j))
#define XB_XSUB(j)  (1280 + 64 * (j))
#define XB_XGEN(j)  (2304 + 64 * (j))
#define XB_TOP      3328
#define XB_TOPGEN   3392
#define XCD_BAR_WORDS 3456
#define XB_SPIN_CAP (1u << 18)

__device__ __forceinline__ unsigned xb_ld(unsigned* p)              { return __hip_atomic_load(p, __ATOMIC_RELAXED, __HIP_MEMORY_SCOPE_AGENT); }
__device__ __forceinline__ unsigned xb_add(unsigned* p, unsigned v) { return __hip_atomic_fetch_add(p, v, __ATOMIC_RELAXED, __HIP_MEMORY_SCOPE_AGENT); }
__device__ __forceinline__ unsigned xb_xcc_id() { return (unsigned)__builtin_amdgcn_s_getreg((3 << 11) | 20) & 0xFu; }
#define XB_SPIN(cond, bar) do { unsigned _sp = 0; while (cond) { __builtin_amdgcn_s_sleep(1); \
    if ((++_sp & 255u) == 0u) { if (xb_ld(&(bar)[XB_TMO])) break; if (_sp > XB_SPIN_CAP) { atomicAdd(&(bar)[XB_TMO], 1u); break; } } } } while (0)

struct XcdBarrier {
    unsigned* bar; unsigned x;
    volatile LAS unsigned* st;
};

__device__ __forceinline__ XcdBarrier xcd_barrier_post(unsigned* bar, volatile LAS unsigned* st) {
    XcdBarrier b; b.bar = bar; b.x = xb_xcc_id(); b.st = st;
    if (threadIdx.x == 0) (void)xb_add(&bar[XB_XCNT(b.x)], 1u);
    return b;
}
__device__ __forceinline__ void xcd_barrier_complete(unsigned* bar, unsigned x, unsigned& nloc, unsigned& nx) {
    const unsigned G = gridDim.x * gridDim.y * gridDim.z;
    unsigned sum, cnt, mine, sp = 0u;
    for (;;) {
        sum = 0u; cnt = 0u; mine = 0u;
#pragma unroll
        for (unsigned j = 0; j < 16; ++j) { const unsigned c = xb_ld(&bar[XB_XCNT(j)]); sum += c; cnt += (c > 0u) ? 1u : 0u; mine = (j == x) ? c : mine; }
        if (sum == G) break;
        __builtin_amdgcn_s_sleep(1);
        if ((++sp & 255u) == 0u) { if (xb_ld(&bar[XB_TMO])) break; if (sp > XB_SPIN_CAP) { atomicAdd(&bar[XB_TMO], 1u); break; } }
    }
    nloc = mine > 0u ? mine : 1u; nx = cnt > 0u ? cnt : 1u;
}

__device__ __forceinline__ void xcd_barrier(const XcdBarrier& b) {
    asm volatile("s_waitcnt vmcnt(0)" ::: "memory");
    __syncthreads();
    if (threadIdx.x == 0) {
        unsigned* bar = b.bar;
        __builtin_amdgcn_s_waitcnt(0);
        unsigned nloc = b.st[0], nx = b.st[1];
        if (nloc == 0u) { xcd_barrier_complete(bar, b.x, nloc, nx); b.st[0] = nloc; b.st[1] = nx; }
        const unsigned old = xb_add(&bar[XB_XSUB(b.x)], 1u);
        const unsigned gen = old / nloc;
        if (old + 1u == (gen + 1u) * nloc) {
            __builtin_amdgcn_fence(__ATOMIC_RELEASE, "agent");
            asm volatile("s_waitcnt vmcnt(0)" ::: "memory");
            const unsigned og = xb_add(&bar[XB_TOP], 1u);
            const unsigned tg = og / nx;
            if (og + 1u == (tg + 1u) * nx) xb_add(&bar[XB_TOPGEN], 1u);
            else XB_SPIN(xb_ld(&bar[XB_TOPGEN]) == tg, bar);
            __builtin_amdgcn_fence(__ATOMIC_ACQUIRE, "agent");
            xb_add(&bar[XB_XGEN(b.x)], 1u);
            asm volatile("s_waitcnt vmcnt(0)" ::: "memory");
        } else {
            XB_SPIN(xb_ld(&bar[XB_XGEN(b.x)]) == gen, bar);
            __builtin_amdgcn_fence(__ATOMIC_ACQUIRE, "agent");
            asm volatile("s_waitcnt vmcnt(0)" ::: "memory");
        }
    }
    __syncthreads();
}

#ifndef PROBE_REP
#define PROBE_REP 0
#endif
template <class Tp> __device__ __forceinline__ Tp* launder(Tp* p) { unsigned long long v = (unsigned long long)p; asm volatile("" : "+s"(v)); return (Tp*)v; }
template <class Tp> __device__ __forceinline__ GAS Tp* launder(GAS Tp* p) { unsigned long long v = (unsigned long long)p; asm volatile("" : "+s"(v)); return (GAS Tp*)v; }
__global__ void __launch_bounds__(512, 2) hymba_fwd(Args A) {
    extern __shared__ __attribute__((aligned(16))) unsigned char smem[];
    LAS unsigned char* lds = (LAS unsigned char*)smem;
    cg::grid_group grid = cg::this_grid();
    const int tid0 = threadIdx.x, wave = __builtin_amdgcn_readfirstlane(tid0 >> 6);
    GAS unsigned char* ws0 = A.ws;
#define HB ((GAS bf16*)(ws + WS_HB))
#define MIX ((GAS bf16*)(ws + WS_MIX))
#define Pb ((GAS bf16*)(ws + WS_P))
#define Fb ((GAS float*)(ws + WS_F))
#define SSQ ((GAS float*)(ws + WS_SSQ))
    GAS bf16* SB = (GAS bf16*)A.out;
    const int lo = A.ph_lo, hi = A.ph_hi; int ph = 0;
    volatile LAS unsigned* xst = (volatile LAS unsigned*)(lds + LDS_BYTES - 64);
    if (tid0 < 2) xst[tid0] = 0u;
    __syncthreads();
    const XcdBarrier xbar = xcd_barrier_post((unsigned*)(ws0 + WS_BAR), xst);
#define PH_BEGIN if (ph >= lo && ph < hi) { int tid = tid0; asm volatile("" : "+v"(tid)); const int lane = tid & 63; GAS unsigned char* ws = launder(ws0);
#define PH_END } if (ph >= lo && ph + 1 < hi) { if (hi < 0) grid.sync();   xcd_barrier(xbar); } ++ph;

    for (int layer = 0; layer < 2; ++layer) {
        PH_BEGIN prologue(A, ws, layer, lds, tid, wave, lane); PH_END
        PH_BEGIN
            pg8::Gemm g{(const bf16*)launder(HB), (const bf16*)launder((const GAS bf16*)(ws + W_GU1)), T, NGU, DM}; pg8::StaticOrder S; S.init(T, NGU, gridDim.x, blockIdx.x);
            pg8::EpiGU E{Pb, SSQ};
            pg8::gemm_phase<pg8::EpiGU, pg8::StaticOrder, true, true>(lds, g, S, E);
        PH_END
        PH_BEGIN
            pg8::Gemm g{(const bf16*)launder(Pb), (const bf16*)launder((const GAS bf16*)(ws + W_DN1)), T, DM, FFP}; pg8::StaticOrder S; S.init(T, DM, gridDim.x, blockIdx.x);
            if (layer == 0) { pg8::EpiRES<true> E{A.in[0], HB, SSQ, 0.5f}; pg8::gemm_phase<pg8::EpiRES<true>, pg8::StaticOrder, false, true>(lds, g, S, E); }
            else { pg8::EpiRES<false> E{nullptr, HB, SSQ, 0.5f}; pg8::gemm_phase<pg8::EpiRES<false>, pg8::StaticOrder, false, true>(lds, g, S, E); }
        PH_END
        PH_BEGIN
            pg8::Gemm g{(const bf16*)launder(HB), (const bf16*)launder((const GAS bf16*)(ws + W_IN)), T, NIN, DM}; pg8::StaticOrder S; S.init(T, NIN, gridDim.x, blockIdx.x);
            pg8::EpiIN E{Pb, Fb, SSQ};
            for (int rp = 0; rp < ((PROBE_REP & 4) ? 2 : 1); ++rp)
            pg8::gemm_phase<pg8::EpiIN, pg8::StaticOrder, true, true>(lds, g, S, E);
        PH_END
        PH_BEGIN
            for (int ci = blockIdx.x; ci < 256; ci += gridDim.x) compress_item(ws, ci, lds, tid, wave, lane);
            for (int it = blockIdx.x; it < 1024; it += gridDim.x) hg_step1(ws, SB, it, lds, tid, wave, lane);
        PH_END
        PH_BEGIN hg_scan(ws, SB, tid); PH_END
        PH_BEGIN
            {
                GAS unsigned* ctr = (GAS unsigned*)(ws + WS_BAR) + 3584 + 64 * layer;
                volatile LAS int* slot = (volatile LAS int*)(lds + LDS_BYTES - 32);
                if (tid == 0) slot[0] = (int)__hip_atomic_fetch_add(ctr, 1u, __ATOMIC_RELAXED, __HIP_MEMORY_SCOPE_AGENT);
                __syncthreads();
                int par = 0;
                for (;;) {
                    const int it = slot[par];
                    if (it >= 1536) break;
                    int nxt = 0;
                    if (tid == 0) nxt = (int)__hip_atomic_fetch_add(ctr, 1u, __ATOMIC_RELAXED, __HIP_MEMORY_SCOPE_AGENT);
                    if (it < 512) { for (int rq = 0; rq < ((PROBE_REP & 8) ? 2 : 1); ++rq) nsa_tile(ws, (it & 7) >> 1, it & 1, 63 - (it >> 3), lds, tid, wave, lane); }
                    else hg_step3(ws, SB, A.in[13] + layer * 128, it - 512, lds, tid, wave, lane);
                    if (tid == 0) slot[par ^ 1] = nxt;
                    __syncthreads();
                    par ^= 1;
                }
            }
        PH_END
        PH_BEGIN
            pg8::Gemm g{(const bf16*)launder(MIX), (const bf16*)launder((const GAS bf16*)(ws + W_OUT)), T, DM, DM}; pg8::StaticOrder S; S.init(T, DM, gridDim.x, blockIdx.x);
            pg8::EpiRES<false> E{nullptr, HB, SSQ, 1.0f};
            pg8::gemm_phase<pg8::EpiRES<false>, pg8::StaticOrder, false, true>(lds, g, S, E);
        PH_END
        PH_BEGIN
            pg8::Gemm g{(const bf16*)launder(HB), (const bf16*)launder((const GAS bf16*)(ws + W_GU2)), T, NGU, DM}; pg8::StaticOrder S; S.init(T, NGU, gridDim.x, blockIdx.x);
            pg8::EpiGU E{Pb, SSQ};
            pg8::gemm_phase<pg8::EpiGU, pg8::StaticOrder, true, true>(lds, g, S, E);
        PH_END
        PH_BEGIN
            pg8::Gemm g{(const bf16*)launder(Pb), (const bf16*)launder((const GAS bf16*)(ws + W_DN2)), T, DM, FFP}; pg8::StaticOrder S; S.init(T, DM, gridDim.x, blockIdx.x);
            pg8::EpiRES<false> E{nullptr, HB, SSQ, 0.5f};
            pg8::gemm_phase<pg8::EpiRES<false>, pg8::StaticOrder, false, true>(lds, g, S, E);
        PH_END
    }
    PH_BEGIN
        const GAS float* fn = A.in[18]; GAS float* OUT = A.out;
        for (int row = blockIdx.x * 8 + wave; row < T; row += gridDim.x * 8) {
            const float rs = rstd_of(SSQ, row);
            const GAS u32x2* hr = (const GAS u32x2*)(HB + (size_t)row * DM) + lane; GAS f32x4* orow = (GAS f32x4*)(OUT + (size_t)row * DM) + lane; const GAS f32x4* gn = (const GAS f32x4*)fn + lane;
#pragma unroll
            for (int j = 0; j < 4; ++j) { const u32x2 w = hr[64 * j]; const f32x4 g4 = gn[64 * j]; orow[64 * j] = (f32x4){bflo(w.x) * rs * g4[0], bfhi(w.x) * rs * g4[1], bflo(w.y) * rs * g4[2], bfhi(w.y) * rs * g4[3]}; }
        }
    PH_END
#undef HB
#undef MIX
#undef Pb
#undef Fb
#undef SSQ
#undef PH_BEGIN
#undef PH_END
}

extern "C" void kernel_launch(void* const* d_in, const int* in_sizes, int n_in, void* d_out, int out_size, void* d_ws, size_t ws_size, hipStream_t stream) {
    static int grid = 0;
    if (grid == 0) {
        int dev = 0, cus = 0, per_cu = 0;
        hipGetDevice(&dev);
        hipDeviceGetAttribute(&cus, hipDeviceAttributeMultiprocessorCount, dev);
        if (hipFuncSetAttribute((const void*)hymba_fwd, hipFuncAttributeMaxDynamicSharedMemorySize, LDS_BYTES) != hipSuccess) fprintf(stderr, "hipFuncSetAttribute failed\n");
        if (hipOccupancyMaxActiveBlocksPerMultiprocessor(&per_cu, (const void*)hymba_fwd, 512, LDS_BYTES) != hipSuccess || per_cu < 1) { fprintf(stderr, "occupancy query: %d\n", per_cu); per_cu = 1; }
        (void)hipGetLastError();
        grid = cus * 1;
        if (n_in != 19 || ws_size < WS_END) fprintf(stderr, "unexpected n_in %d / ws %zu\n", n_in, ws_size);
    }
    (void)hipMemsetAsync((unsigned char*)d_ws + WS_BAR, 0, 16384, stream);
    Args a{};
    for (int i = 0; i < 19; ++i) a.in[i] = (const GAS float*)d_in[i];
    a.out = (GAS float*)d_out; a.ws = (GAS unsigned char*)d_ws; a.ph_lo = 0; a.ph_hi = 1000;
    void* args[] = {&a};
    hipError_t e = hipLaunchCooperativeKernel((const void*)hymba_fwd, dim3(grid), dim3(512), args, LDS_BYTES, stream);
    if (e != hipSuccess) fprintf(stderr, "cooperative launch failed: %s (grid %d)\n", hipGetErrorString(e), grid);
}
```

```cpp
#include <hip/hip_runtime.h>
#include <hip/hip_cooperative_groups.h>
#include <cstdio>
#include <cstdint>
namespace cg = cooperative_groups;
#ifndef PROBE_REP
#define PROBE_REP 0
#endif
namespace pg8 {
#define PG8_LAS __attribute__((address_space(3)))
typedef unsigned short bf16_t;
typedef short bf16x8 __attribute__((ext_vector_type(8)));
typedef float f32x4 __attribute__((ext_vector_type(4)));
typedef unsigned u32x4 __attribute__((ext_vector_type(4)));
constexpr int BM = 256, BK = 64, HALF = 128, HTB = HALF * BK * 2  , STAGE_BYTES = 8 * HTB, NXCD = 8, WGM = 8;

__host__ __device__ __forceinline__ int lds_byte(int r, int c) { const int st = (r >> 4) * 2 + (c >> 5), rr = r & 15, cc = c & 31, ob = rr * 64 + cc * 2; return st * 1024 + (ob ^ (((ob >> 9) & 1) << 5)); }
__host__ __device__ __forceinline__ void stage_rc(int b, int& R, int& C) { const int st = b / 1024, sb = b % 1024, swz = sb ^ (((sb >> 9) & 1) << 5); R = (st >> 1) * 16 + swz / 64; C = (st & 1) * 32 + (swz % 64) / 2; }
__host__ __device__ __forceinline__ int perm32(int rho) { const int n = rho >> 4, i = rho & 15; return 8 * (i >> 2) + 4 * n + (i & 3); }

struct Unit { int pm, pn; };
struct Gemm { const bf16_t* A; const bf16_t* Bt; int M, N, K; };

struct StaticOrder {
    int nM, nN, nwg, G, c;
    __host__ __device__ void init(int M, int N, int G_, int c_) { nM = M / BM; nN = N / BM; nwg = nM * nN; G = G_; c = c_; }
    __host__ __device__ bool next(int i, Unit& u) const {
        const long L = (long)i * G + c; if (L >= nwg) return false;
        int wgid = (int)L; { const int q = nwg / NXCD, r = nwg % NXCD, xcd = wgid % NXCD, off = wgid / NXCD; wgid = (xcd < r ? xcd * (q + 1) : r * (q + 1) + (xcd - r) * q) + off; }
        const int nig = WGM * nN, gid = wgid / nig, fm = gid * WGM, gsz = (nM - fm) < WGM ? (nM - fm) : WGM;
        u.pm = fm + ((wgid % nig) % gsz); u.pn = (wgid % nig) / gsz; return true;
    }
    __device__ __forceinline__ void a_ready(const Unit&) const {}
    __device__ __forceinline__ void done(const Unit&) const {}
};

__device__ __forceinline__ unsigned cvt_pk_bf16(float lo, float hi) { unsigned r; asm volatile("v_cvt_pk_bf16_f32 %0, %1, %2" : "=v"(r) : "v"(lo), "v"(hi)); return r; }
template <class Epi, class Sched, bool ALIGN_EPI = false, bool SP2 = false>
__device__ __forceinline__ void gemm_phase(PG8_LAS unsigned char* lds, const Gemm g, const Sched& S, const Epi& E) {
    int tid_l = threadIdx.x; asm volatile("" : "+v"(tid_l)); const int tid = tid_l, wid = __builtin_amdgcn_readfirstlane(tid >> 6), lane = tid & 63, wr = wid >> 2, wc = wid & 3, fr = lane & 15, fq = lane >> 4;
    const int K = g.K, nt = K / BK;
    unsigned voffA[2], voffB[2];
#pragma unroll
    for (int i = 0; i < 2; ++i) { int R, C; stage_rc(tid * 16 + i * 8192, R, C); const int Rb = Epi::PERM ? ((R & ~31) + perm32(R & 31)) : R;
        voffA[i] = (unsigned)(R * K + C) * 2u; voffB[i] = (unsigned)(Rb * K + C) * 2u; }
    const size_t kstep = (size_t)(BK * 2);
    const size_t hstep = (size_t)HALF * K * 2;
    const size_t tstep = 2 * hstep;
    const unsigned ldsw = (unsigned)wid * 1024u;
    const int aoff = lds_byte(wr * 64 + fr, fq * 8), boff = lds_byte(wc * 32 + fr, fq * 8);
#define PG8_SA(b, h) (((b) * 2 + (h)) * HTB)
#define PG8_SB(b, h) ((4 + (b) * 2 + (h)) * HTB)
#define PG8_STAGE(bufoff, gbase, voff) do { _Pragma("unroll") for (int _i = 0; _i < 2; ++_i) \
        __builtin_amdgcn_global_load_lds((const unsigned*)((const char*)(gbase) + (voff)[_i]), (PG8_LAS unsigned*)(lds + (bufoff) + ldsw + _i * 8192), 16, 0, 0); } while (0)
#define PG8_LDA(dst, b, h) do { _Pragma("unroll") for (int m = 0; m < 4; ++m) _Pragma("unroll") for (int k = 0; k < 2; ++k) dst[m][k] = *(const PG8_LAS bf16x8*)(lds + PG8_SA(b, h) + aoff + m * 2048 + k * 1024); } while (0)
#define PG8_LDB(dst, b, h) do { _Pragma("unroll") for (int n = 0; n < 2; ++n) _Pragma("unroll") for (int k = 0; k < 2; ++k) dst[n][k] = *(const PG8_LAS bf16x8*)(lds + PG8_SB(b, h) + boff + n * 2048 + k * 1024); } while (0)
#define PG8_MMA(ai, bj, At, Bt) do { __builtin_amdgcn_s_setprio(1); _Pragma("unroll") for (int m = 0; m < 4; ++m) _Pragma("unroll") for (int n = 0; n < 2; ++n) _Pragma("unroll") for (int k = 0; k < 2; ++k) \
        acc[ai][bj][m][n] = __builtin_amdgcn_mfma_f32_16x16x32_bf16(Bt[n][k], At[m][k], acc[ai][bj][m][n], 0, 0, 0); __builtin_amdgcn_s_setprio(0); } while (0)
#define PG8_WAIT_V(n) asm volatile("s_waitcnt vmcnt(" #n ")" ::: "memory")
#define PG8_WAIT_L(n) asm volatile("s_waitcnt lgkmcnt(" #n ")" ::: "memory")
#define PG8_BAR __builtin_amdgcn_s_barrier()
#define PG8_SCHED __builtin_amdgcn_sched_barrier(0)
    Unit cur, nxt; int ui = 0;
    if (!S.next(0, cur)) return;
    f32x4 acc[2][2][4][2];
#pragma unroll
    for (int a = 0; a < 2; ++a)
#pragma unroll
        for (int b = 0; b < 2; ++b)
#pragma unroll
            for (int m = 0; m < 4; ++m)
#pragma unroll
                for (int n = 0; n < 2; ++n) acc[a][b][m][n] = (f32x4){0.f, 0.f, 0.f, 0.f};
    bf16x8 At[4][2], B0[2][2], B1[2][2];
    const char* cA = (const char*)g.A + (size_t)cur.pm * tstep; const char* cB = (const char*)g.Bt + (size_t)cur.pn * tstep;
    S.a_ready(cur);
    if constexpr (SP2) {
        PG8_STAGE(PG8_SB(0, 0), cB, voffB); PG8_STAGE(PG8_SB(0, 1), cB + hstep, voffB); PG8_STAGE(PG8_SA(0, 0), cA, voffA); PG8_STAGE(PG8_SA(0, 1), cA + hstep, voffA);
        if (wr == 1) PG8_BAR;
        PG8_WAIT_V(2); PG8_BAR;
        PG8_STAGE(PG8_SB(1, 0), cB + kstep, voffB); PG8_STAGE(PG8_SA(1, 0), cA + kstep, voffA); PG8_STAGE(PG8_SB(1, 1), cB + hstep + kstep, voffB);
        PG8_WAIT_V(6); PG8_BAR;
    } else {
        PG8_STAGE(PG8_SB(0, 0), cB, voffB); PG8_STAGE(PG8_SA(0, 0), cA, voffA); PG8_STAGE(PG8_SB(0, 1), cB + hstep, voffB); PG8_STAGE(PG8_SA(0, 1), cA + hstep, voffA);
        if (wr == 1) PG8_BAR;
        PG8_WAIT_V(4); PG8_BAR;
        PG8_STAGE(PG8_SB(1, 0), cB + kstep, voffB); PG8_STAGE(PG8_SA(1, 0), cA + kstep, voffA); PG8_STAGE(PG8_SB(1, 1), cB + hstep + kstep, voffB);
        PG8_WAIT_V(6); PG8_BAR;
    }
    for (;;) {
        const bool has_next = S.next(ui + 1, nxt);
        const char* nA = has_next ? (const char*)g.A + (size_t)nxt.pm * tstep : cA; const char* nB = has_next ? (const char*)g.Bt + (size_t)nxt.pn * tstep : cB;
        for (int t = 0; t < nt; t += 2) {
            const bool last = (t == nt - 2);
            const char* a1 = cA + (size_t)(t + 1) * kstep;
            const char* a2 = last ? nA : cA + (size_t)(t + 2) * kstep; const char* b2 = last ? nB : cB + (size_t)(t + 2) * kstep;
            const char* a3 = a2 + kstep; const char* b3 = b2 + kstep;
            if (last && has_next) S.a_ready(nxt);
            if constexpr (SP2) {
            PG8_LDB(B0, 0, 0); PG8_LDB(B1, 0, 1); PG8_SCHED; PG8_LDA(At, 0, 0); PG8_STAGE(PG8_SA(1, 1), a1 + hstep, voffA);
            PG8_WAIT_V(8); PG8_WAIT_L(0); PG8_BAR; PG8_MMA(0, 0, At, B0); PG8_MMA(0, 1, At, B1); PG8_BAR; PG8_SCHED;
            PG8_LDA(At, 0, 1); PG8_STAGE(PG8_SB(0, 0), b2, voffB); PG8_STAGE(PG8_SB(0, 1), b2 + hstep, voffB); PG8_STAGE(PG8_SA(0, 0), a2, voffA);
            PG8_WAIT_V(8); PG8_WAIT_L(0); PG8_BAR; PG8_MMA(1, 0, At, B0); PG8_MMA(1, 1, At, B1); PG8_BAR; PG8_SCHED;
            PG8_LDB(B0, 1, 0); PG8_LDB(B1, 1, 1); PG8_SCHED; PG8_LDA(At, 1, 0); PG8_STAGE(PG8_SA(0, 1), a2 + hstep, voffA);
            PG8_WAIT_V(8); PG8_WAIT_L(0); PG8_BAR; PG8_MMA(0, 0, At, B0); PG8_MMA(0, 1, At, B1); PG8_BAR; PG8_SCHED;
            PG8_LDA(At, 1, 1); PG8_STAGE(PG8_SB(1, 0), b3, voffB); PG8_STAGE(PG8_SB(1, 1), b3 + hstep, voffB); PG8_STAGE(PG8_SA(1, 0), a3, voffA);
            PG8_WAIT_V(8); PG8_WAIT_L(0); PG8_BAR; PG8_MMA(1, 0, At, B0); PG8_MMA(1, 1, At, B1); PG8_BAR; PG8_SCHED;
            } else {
            PG8_LDB(B0, 0, 0); PG8_SCHED; PG8_LDA(At, 0, 0); PG8_STAGE(PG8_SA(1, 1), a1 + hstep, voffA);
            PG8_WAIT_L(8); PG8_BAR; PG8_WAIT_L(0); PG8_MMA(0, 0, At, B0); PG8_BAR; PG8_SCHED;
            PG8_LDB(B1, 0, 1); PG8_STAGE(PG8_SB(0, 0), b2, voffB);
            PG8_BAR; PG8_WAIT_L(0); PG8_MMA(0, 1, At, B1); PG8_BAR;
            PG8_LDA(At, 0, 1); PG8_STAGE(PG8_SA(0, 0), a2, voffA);
            PG8_BAR; PG8_WAIT_L(0); PG8_MMA(1, 0, At, B0); PG8_BAR; PG8_SCHED;
            PG8_STAGE(PG8_SB(0, 1), b2 + hstep, voffB);
            PG8_WAIT_V(6); PG8_BAR; PG8_MMA(1, 1, At, B1); PG8_BAR;
            PG8_LDB(B0, 1, 0); PG8_SCHED; PG8_LDA(At, 1, 0); PG8_STAGE(PG8_SA(0, 1), a2 + hstep, voffA);
            PG8_WAIT_L(8); PG8_BAR; PG8_WAIT_L(0); PG8_MMA(0, 0, At, B0); PG8_BAR; PG8_SCHED;
            PG8_LDB(B1, 1, 1); PG8_STAGE(PG8_SB(1, 0), b3, voffB);
            PG8_BAR; PG8_WAIT_L(0); PG8_MMA(0, 1, At, B1); PG8_BAR;
            PG8_LDA(At, 1, 1); PG8_STAGE(PG8_SA(1, 0), a3, voffA);
            PG8_BAR; PG8_WAIT_L(0); PG8_MMA(1, 0, At, B0); PG8_BAR; PG8_SCHED;
            PG8_STAGE(PG8_SB(1, 1), b3 + hstep, voffB);
            PG8_WAIT_V(6); PG8_BAR; PG8_MMA(1, 1, At, B1); PG8_BAR;
            }
        }
        if constexpr (ALIGN_EPI) { if (wr == 0) PG8_BAR; }
        if constexpr (!Epi::AFTER_DRAIN) { E(acc, cur, wr, wc, fr, fq); S.done(cur); }
        if (!has_next) break;
#pragma unroll
        for (int a = 0; a < 2; ++a)
#pragma unroll
            for (int b = 0; b < 2; ++b)
#pragma unroll
                for (int m = 0; m < 4; ++m)
#pragma unroll
                    for (int n = 0; n < 2; ++n) acc[a][b][m][n] = (f32x4){0.f, 0.f, 0.f, 0.f};
        cur = nxt; cA = nA; cB = nB; ++ui;
        if constexpr (ALIGN_EPI) { if (wr == 1) PG8_BAR; }
    }
    PG8_WAIT_V(0);
    if constexpr (!ALIGN_EPI) { if (wr == 0) PG8_BAR; }
    PG8_BAR;
    if constexpr (Epi::AFTER_DRAIN) { E.fused(acc, cur, wr, wc, fr, fq, lds, wid, lane); S.done(cur); }
#undef PG8_SA
#undef PG8_SB
#undef PG8_STAGE
#undef PG8_LDA
#undef PG8_LDB
#undef PG8_MMA
#undef PG8_WAIT_V
#undef PG8_WAIT_L
#undef PG8_BAR
#undef PG8_SCHED
}
}

#define LAS __attribute__((address_space(3)))
#define GAS __attribute__((address_space(1)))
typedef unsigned short bf16;
typedef short bf16x8 __attribute__((ext_vector_type(8)));
typedef short s16x4 __attribute__((ext_vector_type(4)));
typedef float f32x4 __attribute__((ext_vector_type(4)));
typedef float f32x2 __attribute__((ext_vector_type(2)));
typedef float f32x16 __attribute__((ext_vector_type(16)));
typedef unsigned u32x4 __attribute__((ext_vector_type(4)));
typedef unsigned u32x2 __attribute__((ext_vector_type(2)));

constexpr int T = 16384, SEQ = 4096, DM = 1024, FF = 2752, FFP = 2816, NGU = 5632, NIN = 3584, NINSRC = 3352;
constexpr int PW = 2816, FW = 544;
constexpr float EPS = 1e-6f, LOG2E = 1.4426950408889634f, NEGB = -1e30f;
constexpr int PC_Q = 0, PC_KC = 512, PC_VC = 640, PC_KS = 768, PC_VS = 896, PC_KW = 1024, PC_VW = 1152, PC_HQ = 1280, PC_HI = 1792, PC_HG = 2304;
constexpr int FC_HF = 0, FC_GATE = 512;

constexpr size_t MiB = 1u << 20;
constexpr size_t W_GU1 = 0, W_DN1 = 11 * MiB, W_IN = W_DN1 + 5 * MiB + MiB / 2, W_OUT = W_IN + 7 * MiB, W_GU2 = W_OUT + 2 * MiB, W_DN2 = W_GU2 + 11 * MiB,
                 W_C1K = W_DN2 + 5 * MiB + MiB / 2, W_C1V = W_C1K + MiB, W_C2K = W_C1V + MiB, W_C2V = W_C2K + 32768;
constexpr size_t WS_SSQ = 45 * MiB, WS_KC = 46 * MiB, WS_VC = WS_KC + 262144, WS_DC = WS_VC + 262144, WS_CB = 47 * MiB, WS_LB = WS_CB + 32768;
constexpr size_t WS_HB = 49 * MiB, WS_MIX = 81 * MiB, WS_P = 113 * MiB, WS_F = 201 * MiB, WS_QG = 235 * MiB, WS_END = 251 * MiB;
constexpr size_t WS_BAR = WS_LB + 4096;
static_assert(W_C2V + 32768 <= WS_SSQ, "weights fit");
constexpr int LDS_BYTES = 147456;

__device__ __forceinline__ unsigned pk_bf16(float lo, float hi) {
    typedef __bf16 b2 __attribute__((ext_vector_type(2)));
    f32x2 v = {lo, hi}; b2 b = __builtin_convertvector(v, b2); return __builtin_bit_cast(unsigned, b);
}
__device__ __forceinline__ float bflo(unsigned u) { return __uint_as_float(u << 16); }
__device__ __forceinline__ float bfhi(unsigned u) { return __uint_as_float(u & 0xffff0000u); }
__device__ __forceinline__ float fexp2(float x) { return __builtin_amdgcn_exp2f(x); }
__device__ __forceinline__ float fexp(float x) { return __builtin_amdgcn_exp2f(x * LOG2E); }
__device__ __forceinline__ float frcp(float x) { return __builtin_amdgcn_rcpf(x); }
__device__ __forceinline__ float sigmoidf_(float x) { return frcp(1.0f + fexp(-x)); }
__device__ __forceinline__ float siluf_(float x) { return x * sigmoidf_(x); }
__device__ __forceinline__ float gelu_tanh(float x) { const float u = 0.7978845608028654f * (x + 0.044715f * x * x * x); return x * sigmoidf_(2.0f * u); }
__device__ __forceinline__ float wave_sum(float v) {
#pragma unroll
    for (int o = 1; o < 64; o <<= 1) v += __shfl_xor(v, o);
    return v;
}
__device__ __forceinline__ f32x4 mfma16(bf16x8 a, bf16x8 b, f32x4 c) { return __builtin_amdgcn_mfma_f32_16x16x32_bf16(a, b, c, 0, 0, 0); }
__device__ __forceinline__ f32x16 mfma32(bf16x8 a, bf16x8 b, f32x16 c) { return __builtin_amdgcn_mfma_f32_32x32x16_bf16(a, b, c, 0, 0, 0); }
__device__ __forceinline__ float rstd_from(const f32x4 a) { return 1.0f / sqrtf(((a[0] + a[1]) + (a[2] + a[3])) * (1.0f / DM) + EPS); }
__device__ __forceinline__ float rstd_of(const GAS float* ssq, int row) { return rstd_from(*(const GAS f32x4*)(ssq + (unsigned)(row * 4))); }

namespace pg8 {
struct EpiGU {
    static constexpr bool PERM = true, AFTER_DRAIN = false;
    GAS bf16_t* act; const GAS float* ssq;
    __device__ __forceinline__ void operator()(const f32x4 (&acc)[2][2][4][2], const Unit& u, int wr, int wc, int fr, int fq) const {
        int row0 = u.pm * BM + wr * 64 + fr; asm volatile("" : "+v"(row0)); const int col = u.pn * 128 + wc * 32 + 8 * fq;
        float rsv[2][4];
#pragma unroll
        for (int ai = 0; ai < 2; ++ai)
#pragma unroll
            for (int m = 0; m < 4; ++m) rsv[ai][m] = rstd_of(ssq, row0 + ai * HALF + m * 16);
#pragma unroll
        for (int ai = 0; ai < 2; ++ai)
#pragma unroll
            for (int m = 0; m < 4; ++m) {
                const int row = row0 + ai * HALF + m * 16; const float rs = rsv[ai][m];
                float a[8];
#pragma unroll
                for (int n = 0; n < 2; ++n)
#pragma unroll
                    for (int i = 0; i < 4; ++i) { const float g = acc[ai][0][m][n][i] * rs, up = acc[ai][1][m][n][i] * rs; a[n * 4 + i] = siluf_(g) * up; }
                u32x4 w; w.x = pk_bf16(a[0], a[1]); w.y = pk_bf16(a[2], a[3]); w.z = pk_bf16(a[4], a[5]); w.w = pk_bf16(a[6], a[7]);
                __builtin_nontemporal_store(w, (GAS u32x4*)(act + (unsigned)(row * FFP + col)));
                asm volatile("" ::: "memory");
            }
    }
};
struct EpiIN {
    static constexpr bool PERM = true, AFTER_DRAIN = false;
    GAS bf16_t* P; GAS float* F; const GAS float* ssq;
    __device__ __forceinline__ void operator()(const f32x4 (&acc)[2][2][4][2], const Unit& u, int wr, int wc, int fr, int fq) const {
        int row0 = u.pm * BM + wr * 64 + fr; asm volatile("" : "+v"(row0)); const int pn = u.pn;
        const bool isf = (pn == 7 || pn == 8 || pn == 13);
        const int pbase = (pn < 7 ? 256 * pn : 256 * (pn - 2)); const float sc = pn < 2 ? 0.125f * LOG2E : 1.0f;
        const int fbase = (pn == 13) ? 512 : 256 * (pn - 7);
        float rsv[2][4];
#pragma unroll
        for (int ai = 0; ai < 2; ++ai)
#pragma unroll
            for (int m = 0; m < 4; ++m) rsv[ai][m] = rstd_of(ssq, row0 + ai * HALF + m * 16) * sc;
#pragma unroll
        for (int ai = 0; ai < 2; ++ai)
#pragma unroll
            for (int m = 0; m < 4; ++m) {
                const int row = row0 + ai * HALF + m * 16; const float rs = rsv[ai][m];
#pragma unroll
                for (int bj = 0; bj < 2; ++bj) {
                    const int c = bj * HALF + wc * 32 + 8 * fq;
                    const f32x4 v0 = acc[ai][bj][m][0] * rs, v1 = acc[ai][bj][m][1] * rs;
                    if (isf) {
                        if (pn != 13 || c < 32) { GAS float* d = F + (unsigned)(row * FW + fbase + c); *(f32x4*)d = v0; *(GAS f32x4*)(d + 4) = v1; }
                    } else {
                        u32x4 w; w.x = pk_bf16(v0[0], v0[1]); w.y = pk_bf16(v0[2], v0[3]); w.z = pk_bf16(v1[0], v1[1]); w.w = pk_bf16(v1[2], v1[3]);
                        *(GAS u32x4*)(P + (unsigned)(row * PW + pbase + c)) = w;
                    }
                }
                asm volatile("" ::: "memory");
            }
    }
};
template <bool XSRC>
struct EpiRES {
    static constexpr bool PERM = false, AFTER_DRAIN = true;
    const GAS float* xsrc; GAS bf16_t* hb; GAS float* ssq; float alpha;
    __device__ __forceinline__ void fused(f32x4 (&acc)[2][2][4][2], const Unit& u, int wr, int wc, int fr, int fq, PG8_LAS unsigned char* lds, int wid, int lane) const {
        int row0 = u.pm * BM + wr * 64 + fr; asm volatile("" : "+v"(row0)); const int col0 = u.pn * BM + wc * 32 + 4 * fq;
        PG8_LAS float* part = (PG8_LAS float*)lds;
#pragma unroll
        for (int ai = 0; ai < 2; ++ai) {
            f32x4 pre[4][2][2];
#pragma unroll
            for (int m = 0; m < 4; ++m)
#pragma unroll
                for (int bj = 0; bj < 2; ++bj)
#pragma unroll
                    for (int n = 0; n < 2; ++n) {
                        const unsigned off = (unsigned)((row0 + ai * HALF + m * 16) * DM + col0 + bj * HALF + n * 16);
                        if (XSRC) pre[m][bj][n] = __builtin_nontemporal_load((const GAS f32x4*)(xsrc + off));
                        else { const u32x2 w = *(const GAS u32x2*)(hb + off); pre[m][bj][n] = (f32x4){bflo(w.x), bfhi(w.x), bflo(w.y), bfhi(w.y)}; }
                    }
#pragma unroll
            for (int m = 0; m < 4; ++m) {
                const int row = row0 + ai * HALF + m * 16; float sq = 0.f;
#pragma unroll
                for (int bj = 0; bj < 2; ++bj)
#pragma unroll
                    for (int n = 0; n < 2; ++n) {
                        const unsigned off = (unsigned)(row * DM + col0 + bj * HALF + n * 16);
                        const f32x4 o = pre[m][bj][n] + acc[ai][bj][m][n] * alpha;
                        u32x2 w; w.x = pk_bf16(o[0], o[1]); w.y = pk_bf16(o[2], o[3]); *(GAS u32x2*)(hb + off) = w;
                        sq += (o[0] * o[0] + o[1] * o[1]) + (o[2] * o[2] + o[3] * o[3]);
                    }
                sq += __shfl_xor(sq, 16); sq += __shfl_xor(sq, 32);
                if (fq == 0) part[(ai * HALF + wr * 64 + m * 16 + fr) * 4 + wc] = sq;
            }
            asm volatile("" ::: "memory");
        }
        asm volatile("s_waitcnt lgkmcnt(0)" ::: "memory"); __builtin_amdgcn_s_barrier(); asm volatile("" ::: "memory");
        const int t = wid * 64 + lane;
        if (t < 256) { const f32x4 p4 = *(const PG8_LAS f32x4*)(part + t * 4); ssq[(unsigned)((u.pm * BM + t) * 4 + u.pn)] = (p4[0] + p4[1]) + (p4[2] + p4[3]); }
        asm volatile("s_waitcnt lgkmcnt(0)" ::: "memory"); __builtin_amdgcn_s_barrier(); asm volatile("" ::: "memory");
    }
};
}

__device__ __forceinline__ int map_col(int mode, int n, int N) {
    if (mode == 0 || mode == 3) return n < N ? n : -1;
    if (mode == 1) { const int t = n >> 8, r = n & 255, c = 128 * t + (r & 127); return c < FF ? (r < 128 ? c : FF + c) : -1; }
    if (n < 1280) return n;
    if (n < 3328) return n + 24;
    if (n < 3352) return 1280 + (n - 3328);
    return -1;
}
__device__ __forceinline__ void conv_item(const GAS float* W, int K, int N, const GAS float* gain, GAS bf16* WT, int KP, int mode, LAS float* scr, int item, int lane) {
    const int kblks = KP >> 6, nb = item / kblks, kb = item - nb * kblks, k0 = 64 * kb, n0 = 64 * nb;
    const int l16 = lane & 15, kq = lane >> 4;
    const int src = map_col(mode, n0 + 4 * l16, N);
    f32x4 v[16];
#pragma unroll
    for (int i = 0; i < 16; ++i) {
        const int k = k0 + 4 * i + kq;
        v[i] = (f32x4){0.f, 0.f, 0.f, 0.f};
        if (src >= 0 && k < K) { v[i] = __builtin_nontemporal_load((const GAS f32x4*)(W + (size_t)k * N + src)); if (gain) v[i] = v[i] * gain[k]; }
    }
#pragma unroll
    for (int i = 0; i < 16; ++i) {
        LAS float* d = scr + (4 * i + kq) * 65 + 4 * l16;
        d[0] = v[i][0]; d[1] = v[i][1]; d[2] = v[i][2]; d[3] = v[i][3];
    }
    asm volatile("s_waitcnt lgkmcnt(0)" ::: "memory");
    const int c = lane & 7;
#pragma unroll
    for (int j = 0; j < 8; ++j) {
        const int n = (lane >> 3) + 8 * j; const LAS float* s = scr + (8 * c) * 65 + n;
        u32x4 o; o.x = pk_bf16(s[0 * 65], s[1 * 65]); o.y = pk_bf16(s[2 * 65], s[3 * 65]); o.z = pk_bf16(s[4 * 65], s[5 * 65]); o.w = pk_bf16(s[6 * 65], s[7 * 65]);
        if (mode == 3) {
            const int nn = n0 + n, k8 = (k0 >> 3) + c;
            *(GAS u32x4*)(WT + ((size_t)((nn >> 4) * (KP >> 5) + (k8 >> 2)) * 64 + (k8 & 3) * 16 + (nn & 15)) * 8) = o;
        } else *(GAS u32x4*)(WT + (size_t)(n0 + n) * KP + k0 + 8 * c) = o;
    }
    asm volatile("s_waitcnt lgkmcnt(0)" ::: "memory");
}

struct Args { const GAS float* in[19]; GAS float* out; GAS unsigned char* ws; int ph_lo, ph_hi; };

__device__ __forceinline__ void prologue(const Args& A, GAS unsigned char* ws, int layer, LAS unsigned char* lds, int tid, int wave, int lane) {
    LAS float* scr = (LAS float*)(lds + wave * 16640);
    const int gw = blockIdx.x * 8 + wave, NGW = gridDim.x * 8;
    constexpr int I_GU = (NGU / 64) * (DM / 64), I_DN = (DM / 64) * (FFP / 64), I_IN = (NIN / 64) * (DM / 64), I_OUT = (DM / 64) * (DM / 64), I_C1 = (256 / 64) * (2048 / 64), I_C2 = (64 / 64) * (256 / 64);
    constexpr int NITEMS = 2 * I_GU + 2 * I_DN + I_IN + I_OUT + 2 * I_C1 + 2 * I_C2;
    const size_t lgu = (size_t)layer * DM * 2 * FF, ldn = (size_t)layer * FF * DM;
    for (int it = gw; it < NITEMS; it += NGW) {
        int r = it;
        if (r < I_GU) { conv_item(A.in[2] + lgu, DM, 2 * FF, A.in[1] + layer * DM, (GAS bf16*)(ws + W_GU1), DM, 1, scr, r, lane); continue; } r -= I_GU;
        if (r < I_GU) { conv_item(A.in[16] + lgu, DM, 2 * FF, A.in[15] + layer * DM, (GAS bf16*)(ws + W_GU2), DM, 1, scr, r, lane); continue; } r -= I_GU;
        if (r < I_DN) { conv_item(A.in[3] + ldn, FF, DM, nullptr, (GAS bf16*)(ws + W_DN1), FFP, 0, scr, r, lane); continue; } r -= I_DN;
        if (r < I_DN) { conv_item(A.in[17] + ldn, FF, DM, nullptr, (GAS bf16*)(ws + W_DN2), FFP, 0, scr, r, lane); continue; } r -= I_DN;
        if (r < I_IN) { conv_item(A.in[5] + (size_t)layer * DM * NINSRC, DM, NINSRC, A.in[4] + layer * DM, (GAS bf16*)(ws + W_IN), DM, 2, scr, r, lane); continue; } r -= I_IN;
        if (r < I_OUT) { conv_item(A.in[14] + (size_t)layer * DM * DM, DM, DM, nullptr, (GAS bf16*)(ws + W_OUT), DM, 0, scr, r, lane); continue; } r -= I_OUT;
        if (r < I_C1) { conv_item(A.in[8] + (size_t)layer * 2048 * 256, 2048, 256, nullptr, (GAS bf16*)(ws + W_C1K), 2048, 3, scr, r, lane); continue; } r -= I_C1;
        if (r < I_C1) { conv_item(A.in[10] + (size_t)layer * 2048 * 256, 2048, 256, nullptr, (GAS bf16*)(ws + W_C1V), 2048, 3, scr, r, lane); continue; } r -= I_C1;
        if (r < I_C2) { conv_item(A.in[9] + (size_t)layer * 256 * 64, 256, 64, nullptr, (GAS bf16*)(ws + W_C2K), 256, 0, scr, r, lane); continue; } r -= I_C2;
        conv_item(A.in[11] + (size_t)layer * 256 * 64, 256, 64, nullptr, (GAS bf16*)(ws + W_C2V), 256, 0, scr, r, lane);
    }
    if (layer == 0) {
        GAS bf16* hb = (GAS bf16*)(ws + WS_HB); GAS float* ssq = (GAS float*)(ws + WS_SSQ); const GAS float* x = A.in[0];
        for (int row = gw; row < T; row += 4 * NGW) {
            f32x4 v[4][4];
#pragma unroll
            for (int r = 0; r < 4; ++r) { const int rw = row + r * NGW; if (rw < T) { const GAS f32x4* xr = (const GAS f32x4*)(x + (size_t)rw * DM) + lane;
#pragma unroll
                for (int j = 0; j < 4; ++j) v[r][j] = __builtin_nontemporal_load(xr + 64 * j); } }
#pragma unroll
            for (int r = 0; r < 4; ++r) { const int rw = row + r * NGW; if (rw < T) { float s = 0.f; GAS u32x2* o = (GAS u32x2*)(hb + (size_t)rw * DM) + lane;
#pragma unroll
                for (int j = 0; j < 4; ++j) { const f32x4 q = v[r][j]; s += (q[0] * q[0] + q[1] * q[1]) + (q[2] * q[2] + q[3] * q[3]); u32x2 w; w.x = pk_bf16(q[0], q[1]); w.y = pk_bf16(q[2], q[3]); o[64 * j] = w; }
                s = wave_sum(s);
                if (lane < 4) ssq[(size_t)rw * 4 + lane] = lane == 0 ? s : 0.f; } }
        }
    }
    __syncthreads();
    const int bx = (int)gridDim.x - 1 - (int)blockIdx.x;
    if (bx < 32) {
        const int kv = bx & 1, part = bx >> 1;
        const GAS float* pos = A.in[kv == 0 ? 6 : 7] + (size_t)layer * 2048; const GAS float* w1 = A.in[kv == 0 ? 8 : 10] + (size_t)layer * 2048 * 256;
        const int n = tid & 255, half = tid >> 8; float s = 0.f;
        const int j0 = part * 128 + half * 64;
#pragma unroll 16
        for (int j = j0; j < j0 + 64; ++j) s += pos[j] * w1[(size_t)j * 256 + n];
        LAS float* red = (LAS float*)(lds + 8 * 16640);
        if (half) red[n] = s;
        __syncthreads();
        if (!half) ((GAS float*)(ws + WS_CB))[(part * 2 + kv) * 256 + n] = s + red[n];
    } else if (bx == 32) {
        const GAS float* lbp = A.in[12]; float v = 0.f;
        if (layer == 1) { const float a0 = lbp[tid], a1 = lbp[512 + tid]; v = 1.0f / (1.0f + expf(a0 - a1)); }
        ((GAS float*)(ws + WS_LB))[tid] = v;
    }
}

#ifndef NTS
#define NTS -1
#endif
#define TACC(k) do { if (NTS >= 0 && blockIdx.x == 0 && tid == 0) { const unsigned long long now_ = __builtin_amdgcn_s_memrealtime(); ((GAS unsigned long long*)(ws + WS_BAR + 16384 + 1024))[k] += now_ - t_prev_; t_prev_ = now_; } } while (0)
#define TSTART unsigned long long t_prev_ = (NTS >= 0) ? __builtin_amdgcn_s_memrealtime() : 0ull
__device__ __forceinline__ void compress_item(GAS unsigned char* ws, int ci, LAS unsigned char* lds, int tid, int wave, int lane) {
    asm volatile("" : "+v"(tid)); lane = tid & 63;
    const int kv = ci >> 6, r0 = (ci & 63) * 32, rr = lane & 15, quad = lane >> 4;
    TSTART;
    const GAS bf16* P = (const GAS bf16*)(ws + WS_P); const GAS bf16* w1t = (const GAS bf16*)(ws + (kv ? W_C1V : W_C1K)); const GAS bf16* w2t = (const GAS bf16*)(ws + (kv ? W_C2V : W_C2K));
    const GAS float* cb = (const GAS float*)(ws + WS_CB) + kv * 256;
    LAS unsigned char* AL = lds;
    LAS bf16* HID = (LAS bf16*)(lds + 32 * 2064);
    const GAS bf16* bp[2];
#pragma unroll
    for (int j = 0; j < 2; ++j) bp[j] = w1t + ((size_t)(2 * wave + j) * 64 * 64 + quad * 16 + rr) * 8;
    f32x4 acc[2][2];
#pragma unroll
    for (int i = 0; i < 2; ++i)
#pragma unroll
        for (int j = 0; j < 2; ++j) acc[i][j] = (f32x4){0.f, 0.f, 0.f, 0.f};
    bf16x8 bcur[8][2], bnxt[8][2];
#pragma unroll
    for (int u = 0; u < 8; ++u)
#pragma unroll
        for (int j = 0; j < 2; ++j) bcur[u][j] = *(const GAS bf16x8*)(bp[j] + u * 512);
#pragma unroll 1
    for (int half = 0; half < 2; ++half) {
        __syncthreads();
#pragma unroll
        for (int c = 0; c < 8; ++c) {
            const int ch = tid + 512 * c, row = ch >> 7, l = (ch >> 3) & 15, piece = ch & 7;
            const int r = r0 + row, b = r >> 9, nb = (r >> 1) & 255, g = r & 1;
            int tok = b * SEQ + nb * 16 + 16 * half + l; tok = tok > T - 1 ? T - 1 : tok;
            const u32x4 v = *(const GAS u32x4*)(P + (size_t)tok * PW + PC_KC + kv * 128 + g * 64 + piece * 8);
            *(LAS u32x4*)(AL + row * 2064 + (l * 64 + piece * 8) * 2) = v;
        }
        __syncthreads();
#pragma unroll 1
        for (int bt = 0; bt < 4; ++bt) {
            const int gnext = (4 * half + bt + 1) * 8;
            if (gnext < 64) {
#pragma unroll
                for (int u = 0; u < 8; ++u)
#pragma unroll
                    for (int j = 0; j < 2; ++j) bnxt[u][j] = *(const GAS bf16x8*)(bp[j] + (gnext + u) * 512);
            }
#pragma unroll
            for (int u = 0; u < 8; ++u) {
                const int ks = 8 * bt + u; bf16x8 a[2];
#pragma unroll
                for (int i = 0; i < 2; ++i) a[i] = *(const LAS bf16x8*)(AL + (16 * i + rr) * 2064 + (32 * ks + 8 * quad) * 2);
#pragma unroll
                for (int i = 0; i < 2; ++i)
#pragma unroll
                    for (int j = 0; j < 2; ++j) acc[i][j] = mfma16(a[i], bcur[u][j], acc[i][j]);
            }
#pragma unroll
            for (int u = 0; u < 8; ++u)
#pragma unroll
                for (int j = 0; j < 2; ++j) bcur[u][j] = bnxt[u][j];
        }
    }
#pragma unroll
    for (int i = 0; i < 2; ++i)
#pragma unroll
        for (int j = 0; j < 2; ++j) {
            const int n = 32 * wave + 16 * j + rr; float bias = 0.f;
#pragma unroll
            for (int pp = 0; pp < 16; ++pp) bias += cb[pp * 512 + n];
#pragma unroll
            for (int e = 0; e < 4; ++e) { const int row = 16 * i + 4 * quad + e; HID[row * 264 + n] = (bf16)(pk_bf16(gelu_tanh(acc[i][j][e] + bias), 0.f) & 0xffffu); }
        }
    __syncthreads();
    {
        const int rti = wave >> 2, cti = wave & 3; f32x4 o = (f32x4){0.f, 0.f, 0.f, 0.f};
#pragma unroll
        for (int ks = 0; ks < 8; ++ks) {
            const bf16x8 a = *(const LAS bf16x8*)(HID + (16 * rti + rr) * 264 + 32 * ks + 8 * quad);
            const bf16x8 b = *(const GAS bf16x8*)(w2t + (size_t)(16 * cti + rr) * 256 + 32 * ks + 8 * quad);
            o = mfma16(a, b, o);
        }
        GAS bf16* dst = (GAS bf16*)(ws + (kv ? WS_VC : WS_KC));
#pragma unroll
        for (int e = 0; e < 4; ++e) {
            const int r = r0 + 16 * rti + 4 * quad + e, b = r >> 9, nb = (r >> 1) & 255, g = r & 1;
            dst[((size_t)(b * 2 + g) * 256 + nb) * 64 + 16 * cti + rr] = nb == 255 ? (bf16)0 : (bf16)(pk_bf16(o[e], 0.f) & 0xffffu);
        }
    }
    TACC(8);
}

__device__ __forceinline__ void hg1_load(GAS unsigned char* ws, int item, int tid, f32x4 (&zr)[4], u32x2 (&hqr)[4], u32x2 (&hir)[4]) {
    const int ch = item & 63, bh = item >> 6, h = bh & 3, b = bh >> 2, tok0 = b * SEQ + ch * 64;
    const GAS bf16* P = (const GAS bf16*)(ws + WS_P); const GAS float* F = (const GAS float*)(ws + WS_F);
#pragma unroll
    for (int i = 0; i < 4; ++i) {
        const int qi = tid + 512 * i, t = qi >> 5, d = (qi & 31) * 4;
        zr[i] = __builtin_nontemporal_load((const GAS f32x4*)(F + (size_t)(tok0 + t) * FW + FC_HF + h * 128 + d));
        const GAS bf16* prow0 = P + (size_t)(tok0 + t) * PW + h * 128 + d;
        hqr[i] = __builtin_nontemporal_load((const GAS u32x2*)(prow0 + PC_HQ)); hir[i] = __builtin_nontemporal_load((const GAS u32x2*)(prow0 + PC_HI));
    }
}
__device__ __forceinline__ void hg_step1(GAS unsigned char* ws, GAS bf16* S, int item, int next_item, f32x4 (&zr)[4], u32x2 (&hqr)[4], u32x2 (&hir)[4], LAS unsigned char* lds, int tid, int wave, int lane) {
    asm volatile("" : "+v"(tid)); lane = tid & 63;
    const int ch = item & 63, bh = item >> 6, h = bh & 3, b = bh >> 2, tok0 = b * SEQ + ch * 64;
    GAS bf16* P = (GAS bf16*)(ws + WS_P); const GAS float* F = (const GAS float*)(ws + WS_F); GAS bf16* MIX = (GAS bf16*)(ws + WS_MIX);
    GAS float* DC = (GAS float*)(ws + WS_DC); const GAS float* LB = (const GAS float*)(ws + WS_LB);
    LAS float* Bc = (LAS float*)lds;
    LAS float* TOT = (LAS float*)(lds + 33792);
    LAS bf16* Qh = (LAS bf16*)(lds + 35840);
    LAS bf16* Kh = (LAS bf16*)(lds + 53248);
    LAS bf16* KgT = (LAS bf16*)(lds + 70656);
    LAS bf16* VT = (LAS bf16*)(lds + 89088);
    LAS bf16* Am = (LAS bf16*)(lds + 107520);
    const int rr = lane & 15, quad = lane >> 4;
    __syncthreads();
    TSTART;
#pragma unroll
    for (int i = 0; i < 4; ++i) {
        const int qi = tid + 512 * i, t = qi >> 5, d = (qi & 31) * 4;
        const f32x4 z = zr[i];
        const f32x4 lb = *(const GAS f32x4*)(LB + h * 128 + d);
        f32x4 lf;
#pragma unroll
        for (int e = 0; e < 4; ++e) { const float f = lb[e] + (1.0f - lb[e]) * sigmoidf_(z[e]); lf[e] = __logf(fmaxf(f, 1e-30f)); }
        *(LAS f32x4*)(Bc + t * 132 + d) = lf;
    }
    __syncthreads();
    {
        const int d = tid & 127, part = tid >> 7; float run = 0.f;
#pragma unroll
        for (int t = 0; t < 16; ++t) { run += Bc[(16 * part + t) * 132 + d]; Bc[(16 * part + t) * 132 + d] = run; }
        TOT[part * 128 + d] = run;
        __syncthreads();
        float off = 0.f;
        for (int p = 0; p < part; ++p) off += TOT[p * 128 + d];
        if (part > 0) {
#pragma unroll
            for (int t = 0; t < 16; ++t) Bc[(16 * part + t) * 132 + d] += off;
        }
    }
    __syncthreads();
    TACC(9);
#pragma unroll
    for (int i = 0; i < 4; ++i) {
        const int qi = tid + 512 * i, t = qi >> 5, d = (qi & 31) * 4;
        const f32x4 z = zr[i];
        const f32x4 lb = *(const GAS f32x4*)(LB + h * 128 + d);
        const u32x2 hq = hqr[i], hi = hir[i];
        const f32x4 bb = *(const LAS f32x4*)(Bc + t * 132 + d), mm = *(const LAS f32x4*)(Bc + 31 * 132 + d), bl = *(const LAS f32x4*)(Bc + 63 * 132 + d);
        const float qv[4] = {bflo(hq.x), bfhi(hq.x), bflo(hq.y), bfhi(hq.y)};
        float qh[4], kh[4], qg[4], kg[4];
#pragma unroll
        for (int e = 0; e < 4; ++e) {
            const float qs = siluf_(qv[e]), kf = (1.0f - lb[e]) * sigmoidf_(-z[e]);
            qh[e] = qs * fexp(bb[e] - mm[e]); kh[e] = kf * fexp(mm[e] - bb[e]); qg[e] = qs * fexp(bb[e]); kg[e] = kf * fexp(bl[e] - bb[e]);
        }
        u32x2 w; w.x = pk_bf16(qh[0], qh[1]); w.y = pk_bf16(qh[2], qh[3]); *(LAS u32x2*)(Qh + t * 136 + d) = w;
        w.x = pk_bf16(kh[0], kh[1]); w.y = pk_bf16(kh[2], kh[3]); *(LAS u32x2*)(Kh + t * 136 + d) = w;
        w.x = pk_bf16(qg[0], qg[1]); w.y = pk_bf16(qg[2], qg[3]); __builtin_nontemporal_store(w, (GAS u32x2*)((GAS bf16*)(ws + WS_QG) + (size_t)(tok0 + t) * 512 + h * 128 + d));
        const unsigned k01 = pk_bf16(kg[0], kg[1]), k23 = pk_bf16(kg[2], kg[3]);
        KgT[(d + 0) * 72 + t] = (bf16)(k01 & 0xffffu); KgT[(d + 1) * 72 + t] = (bf16)(k01 >> 16); KgT[(d + 2) * 72 + t] = (bf16)(k23 & 0xffffu); KgT[(d + 3) * 72 + t] = (bf16)(k23 >> 16);
        VT[(d + 0) * 72 + t] = (bf16)(hi.x & 0xffffu); VT[(d + 1) * 72 + t] = (bf16)(hi.x >> 16); VT[(d + 2) * 72 + t] = (bf16)(hi.y & 0xffffu); VT[(d + 3) * 72 + t] = (bf16)(hi.y >> 16);
        if (t == 63) { f32x4 dcv;
#pragma unroll
            for (int e = 0; e < 4; ++e) dcv[e] = fexp(bl[e]);
            *(GAS f32x4*)(DC + (size_t)item * 128 + d) = dcv; }
    }
    __syncthreads();
    TACC(10);
    if (next_item >= 0) hg1_load(ws, next_item, tid, zr, hqr, hir);
    {
        const int ti = wave >> 1;
#pragma unroll
        for (int q = 0; q < 2; ++q) {
            const int si = (wave & 1) * 2 + q; f32x4 acc = (f32x4){0.f, 0.f, 0.f, 0.f};
            if (si <= ti) {
#pragma unroll
                for (int ks = 0; ks < 4; ++ks) {
                    const bf16x8 a = *(const LAS bf16x8*)(Qh + (16 * ti + rr) * 136 + 32 * ks + 8 * quad);
                    const bf16x8 bq = *(const LAS bf16x8*)(Kh + (16 * si + rr) * 136 + 32 * ks + 8 * quad);
                    acc = mfma16(a, bq, acc);
                }
            }
#pragma unroll
            for (int e = 0; e < 4; ++e) { const int t = 16 * ti + 4 * quad + e, s = 16 * si + rr; const float v = (s <= t) ? acc[e] : 0.f; Am[t * 72 + s] = (bf16)(pk_bf16(v, 0.f) & 0xffffu); }
        }
    }
    asm volatile("s_waitcnt lgkmcnt(0)" ::: "memory"); __builtin_amdgcn_s_barrier(); asm volatile("" ::: "memory");
    {
        const int ti = wave & 3;
#pragma unroll
        for (int q = 0; q < 4; ++q) {
            const int vi = (wave >> 2) * 4 + q; f32x4 acc = (f32x4){0.f, 0.f, 0.f, 0.f};
#pragma unroll
            for (int ks = 0; ks < 2; ++ks) {
                const bf16x8 a = *(const LAS bf16x8*)(VT + (16 * vi + rr) * 72 + 32 * ks + 8 * quad);
                const bf16x8 bq = *(const LAS bf16x8*)(Am + (16 * ti + rr) * 72 + 32 * ks + 8 * quad);
                acc = mfma16(a, bq, acc);
            }
            u32x2 w; w.x = pk_bf16(acc[0], acc[1]); w.y = pk_bf16(acc[2], acc[3]);
            *(GAS u32x2*)(MIX + (size_t)(tok0 + 16 * ti + rr) * DM + 512 + h * 128 + 16 * vi + 4 * quad) = w;
        }
#pragma unroll
        for (int vi = 0; vi < 8; ++vi) {
            f32x4 acc = (f32x4){0.f, 0.f, 0.f, 0.f};
#pragma unroll
            for (int ks = 0; ks < 2; ++ks) {
                const bf16x8 a = *(const LAS bf16x8*)(KgT + (16 * wave + rr) * 72 + 32 * ks + 8 * quad);
                const bf16x8 bq = *(const LAS bf16x8*)(VT + (16 * vi + rr) * 72 + 32 * ks + 8 * quad);
                acc = mfma16(a, bq, acc);
            }
            u32x2 w; w.x = pk_bf16(acc[0], acc[1]); w.y = pk_bf16(acc[2], acc[3]);
            *(GAS u32x2*)(S + (size_t)item * 16384 + (16 * vi + rr) * 128 + 16 * wave + 4 * quad) = w;
        }
    }    TACC(11);
}
__device__ __forceinline__ void hg_scan(GAS unsigned char* ws, GAS bf16* S, int tid, bool dummy = false) {
    const GAS float* DC = (const GAS float*)(ws + WS_DC);
    for (int gt = blockIdx.x * 512 + tid; gt < 131072; gt += gridDim.x * 512) {
        const int bh = gt >> 13, e = (gt & 8191) * 2, d = e & 127;
        float s0 = 0.f, s1 = 0.f;
        GAS unsigned* p = (GAS unsigned*)(S + (size_t)bh * 64 * 16384 + e); const GAS float* dc = DC + (size_t)bh * 64 * 128 + d;
        unsigned sv[16]; f32x2 dv[16];
#pragma unroll
        for (int j = 0; j < 16; ++j) { sv[j] = p[(size_t)j * 8192]; dv[j] = *(const GAS f32x2*)(dc + j * 128); }
#pragma unroll 1
        for (int cb = 0; cb < 4; ++cb) {
            unsigned nsv[16]; f32x2 ndv[16];
            if (cb < 3) {
#pragma unroll
                for (int j = 0; j < 16; ++j) { nsv[j] = p[(size_t)(16 * cb + 16 + j) * 8192]; ndv[j] = *(const GAS f32x2*)(dc + (16 * cb + 16 + j) * 128); }
            }
#pragma unroll
            for (int j = 0; j < 16; ++j) {
                if (!dummy || s0 == 12345.678f) p[(size_t)(16 * cb + j) * 8192] = pk_bf16(s0, s1);
                s0 = dv[j][0] * s0 + bflo(sv[j]); s1 = dv[j][1] * s1 + bfhi(sv[j]);
            }
            if (cb < 3) {
#pragma unroll
                for (int j = 0; j < 16; ++j) { sv[j] = nsv[j]; dv[j] = ndv[j]; }
            }
        }
    }
}
__device__ __forceinline__ void hg_step3(GAS unsigned char* ws, const GAS bf16* Sb, const GAS float* onorm, int item, LAS unsigned char* lds, int tid, int wave, int lane, bool scratch_out = false) {
    asm volatile("" : "+v"(tid)); lane = tid & 63;
    const int ch = item & 63, bh = item >> 6, h = bh & 3, b = bh >> 2, tok0 = b * SEQ + ch * 64;
    const GAS bf16* P = (const GAS bf16*)(ws + WS_P); GAS bf16* MIX = (GAS bf16*)(ws + WS_MIX); const GAS bf16* S = Sb + (size_t)item * 16384;
    LAS float* red = (LAS float*)lds;
    LAS unsigned char* SL = lds + 1024;
    LAS unsigned char* QL = lds + 1024 + 128 * 272;
    const int rr = lane & 15, quad = lane >> 4, ti = wave & 3, vh = wave >> 2, t = 16 * ti + rr, tok = tok0 + t;
    TSTART;
    __syncthreads();
    {
        const GAS bf16* QG = (const GAS bf16*)(ws + WS_QG) + (size_t)tok0 * 512 + h * 128;
#pragma unroll
        for (int i = 0; i < 4; ++i) { const int c = tid + 512 * i, row = c >> 4, piece = c & 15; *(LAS u32x4*)(SL + row * 272 + piece * 16) = __builtin_nontemporal_load((const GAS u32x4*)(S + row * 128 + piece * 8)); }
#pragma unroll
        for (int i = 0; i < 2; ++i) { const int c = tid + 512 * i, row = c >> 4, piece = c & 15; *(LAS u32x4*)(QL + row * 272 + piece * 16) = __builtin_nontemporal_load((const GAS u32x4*)(QG + (size_t)row * 512 + piece * 8)); }
    }
    __syncthreads();
    bf16x8 bq[4];
#pragma unroll
    for (int ks = 0; ks < 4; ++ks) bq[ks] = *(const LAS bf16x8*)(QL + t * 272 + (32 * ks + 8 * quad) * 2);
    f32x4 o[4]; float sq = 0.f;
#pragma unroll
    for (int q = 0; q < 4; ++q) {
        const int vi = 4 * vh + q; f32x4 acc = (f32x4){0.f, 0.f, 0.f, 0.f};
#pragma unroll
        for (int ks = 0; ks < 4; ++ks) { const bf16x8 a = *(const LAS bf16x8*)(SL + (16 * vi + rr) * 272 + (32 * ks + 8 * quad) * 2); acc = mfma16(a, bq[ks], acc); }
        const u32x2 oi = *(const GAS u32x2*)(MIX + (size_t)tok * DM + 512 + h * 128 + 16 * vi + 4 * quad);
        acc[0] += bflo(oi.x); acc[1] += bfhi(oi.x); acc[2] += bflo(oi.y); acc[3] += bfhi(oi.y);
        o[q] = acc; sq += (acc[0] * acc[0] + acc[1] * acc[1]) + (acc[2] * acc[2] + acc[3] * acc[3]);
    }
    sq += __shfl_xor(sq, 16); sq += __shfl_xor(sq, 32);
    __syncthreads();
    if (quad == 0) red[vh * 64 + t] = sq;
    __syncthreads();
    const float rs = 1.0f / sqrtf((red[t] + red[64 + t]) * (1.0f / 128.0f) + EPS);
#pragma unroll
    for (int q = 0; q < 4; ++q) {
        const int v = 16 * (4 * vh + q) + 4 * quad;
        const f32x4 on = *(const GAS f32x4*)(onorm + v);
        const u32x2 g = *(const GAS u32x2*)(P + (size_t)tok * PW + PC_HG + h * 128 + v);
        const float r0 = o[q][0] * rs * on[0] * siluf_(bflo(g.x)), r1 = o[q][1] * rs * on[1] * siluf_(bfhi(g.x)), r2 = o[q][2] * rs * on[2] * siluf_(bflo(g.y)), r3 = o[q][3] * rs * on[3] * siluf_(bfhi(g.y));
        u32x2 w; w.x = pk_bf16(r0, r1); w.y = pk_bf16(r2, r3);
        if (scratch_out) *(GAS u32x2*)((GAS bf16*)(ws + WS_F) + (size_t)tok * (FW * 2) + h * 128 + v) = w;
        else *(GAS u32x2*)(MIX + (size_t)tok * DM + 512 + h * 128 + v) = w;
    }    TACC(12);
}

template <int MODE>
__device__ __forceinline__ void nsa_scores(f32x16& p0, f32x16& p1, const LAS unsigned char* Kt, const LAS unsigned char* qptr, int lane, float base, float sl2) {
    constexpr float STR = (MODE == 0) ? 16.f : 1.f;
    bf16x8 qf[4];
#pragma unroll
    for (int ks = 0; ks < 4; ++ks) qf[ks] = *(const LAS bf16x8*)(qptr + 1024 * ks);
    const LAS unsigned char* kb = Kt + (lane & 31) * 144 + (lane >> 5) * 16;
    const float b1 = base + sl2 * (32.f * STR);
#pragma unroll
    for (int r = 0; r < 16; ++r) { const float c = (float)((r & 3) + 8 * (r >> 2)) * STR; p0[r] = sl2 * c + base; p1[r] = sl2 * c + b1; }
    bf16x8 ka0[4], ka1[4];
#pragma unroll
    for (int ks = 0; ks < 4; ++ks) { ka0[ks] = *(const LAS bf16x8*)(kb + ks * 32); ka1[ks] = *(const LAS bf16x8*)(kb + 32 * 144 + ks * 32); }
    __builtin_amdgcn_sched_barrier(0);
#pragma unroll
    for (int ks = 0; ks < 4; ++ks) { p0 = mfma32(ka0[ks], qf[ks], p0); p1 = mfma32(ka1[ks], qf[ks], p1); }
}
template <int MODE>
__device__ __forceinline__ void nsa_mask(f32x16& p0, f32x16& p1, float d0) {
    constexpr float STR = (MODE == 0) ? 16.f : 1.f;
#pragma unroll
    for (int r = 0; r < 16; ++r) {
        const float c0 = (float)((r & 3) + 8 * (r >> 2)) * STR, c1 = c0 + 32.f * STR;
        bool v0 = d0 >= c0, v1 = d0 >= c1;
        if (MODE == 2) { v0 = v0 && (d0 - c0) < 512.f; v1 = v1 && (d0 - c1) < 512.f; }
        p0[r] = v0 ? p0[r] : -INFINITY; p1[r] = v1 ? p1[r] : -INFINITY;
    }
}
__device__ __forceinline__ float max3f_(float a, float b, float c) { float r; asm("v_max3_f32 %0, %1, %2, %3" : "=v"(r) : "v"(a), "v"(b), "v"(c)); return r; }
typedef short v4i16_t __attribute__((ext_vector_type(4)));
__device__ __forceinline__ s16x4 vtr(const LAS unsigned char* p) { return __builtin_bit_cast(s16x4, __builtin_amdgcn_ds_read_tr16_b64_v4i16((LAS v4i16_t*)p)); }
__device__ __forceinline__ void nsa_softmax_pv(f32x16& p0, f32x16& p1, const LAS unsigned char* Vt, float& m, float& l, f32x16 (&oT)[2], int lane) {
    float mx = max3f_(p0[0], p1[0], p0[1]), mx2 = max3f_(p1[1], p0[2], p1[2]);
#pragma unroll
    for (int r = 3; r < 15; r += 2) { mx = max3f_(mx, p0[r], p1[r]); mx2 = max3f_(mx2, p0[r + 1], p1[r + 1]); }
    mx = max3f_(mx, p0[15], p1[15]);
    mx = max3f_(mx, mx2, __shfl_xor(mx, 32));
    mx = max3f_(mx, mx, __shfl_xor(mx2, 32));
    const float mn = max3f_(m, mx, mx);
    if (__any(mn != m)) {
        const float alpha = fexp2(m - mn); l *= alpha;
#pragma unroll
        for (int r = 0; r < 16; ++r) { oT[0][r] *= alpha; oT[1][r] *= alpha; }
        m = mn;
    }
    float ps = 0.f;
#pragma unroll
    for (int r = 0; r < 16; ++r) { p0[r] = fexp2(p0[r] - mn); p1[r] = fexp2(p1[r] - mn); ps += p0[r] + p1[r]; }
    l += ps;
    const LAS unsigned char* vb = Vt + (4 * (lane >> 5) + ((lane & 15) >> 2)) * 144 + (16 * ((lane >> 4) & 1) + 4 * (lane & 3)) * 2;
#pragma unroll
    for (int half = 0; half < 2; ++half) {
        s16x4 vl[2][2][2];
#pragma unroll
        for (int sl = 0; sl < 2; ++sl)
#pragma unroll
            for (int dt = 0; dt < 2; ++dt) { const int sidx = 2 * half + sl; vl[sl][dt][0] = vtr(vb + (16 * sidx) * 144 + dt * 64); vl[sl][dt][1] = vtr(vb + (16 * sidx + 8) * 144 + dt * 64); }
        __builtin_amdgcn_sched_barrier(0);
#pragma unroll
        for (int sl = 0; sl < 2; ++sl) {
            const f32x16& pp = half ? p1 : p0; const int o = 8 * sl;
            const unsigned w0 = pk_bf16(pp[o + 0], pp[o + 1]), w1 = pk_bf16(pp[o + 2], pp[o + 3]), w2 = pk_bf16(pp[o + 4], pp[o + 5]), w3 = pk_bf16(pp[o + 6], pp[o + 7]);
            const u32x4 wv = {w0, w1, w2, w3}; const bf16x8 bp = __builtin_bit_cast(bf16x8, wv);
#pragma unroll
            for (int dt = 0; dt < 2; ++dt) {
                const bf16x8 av = {vl[sl][dt][0][0], vl[sl][dt][0][1], vl[sl][dt][0][2], vl[sl][dt][0][3], vl[sl][dt][1][0], vl[sl][dt][1][1], vl[sl][dt][1][2], vl[sl][dt][1][3]};
                oT[dt] = mfma32(av, bp, oT[dt]);
            }
        }
    }
}

__device__ __forceinline__ void nsa_load_kv(const GAS bf16* P, int tokb, int kcol, int vcol, int tid, u32x4& kr, u32x4& vr) {
    const int row = tid >> 3, ch = tid & 7; const GAS bf16* p = P + (size_t)(tokb + row) * PW + ch * 8;
    kr = *(const GAS u32x4*)(p + kcol); vr = *(const GAS u32x4*)(p + vcol);
}
__device__ __forceinline__ void nsa_store_kv(LAS unsigned char* Kt, LAS unsigned char* Vt, int tid, const u32x4& kr, const u32x4& vr) {
    const int row = tid >> 3, ch = tid & 7;
    *(LAS u32x4*)(Kt + row * 144 + ch * 16) = kr;
    *(LAS u32x4*)(Vt + row * 144 + ch * 16) = vr;
}

template <int MODE>
__device__ __forceinline__ void nsa_step(const LAS unsigned char* qf, int jc, int qt, int qpos, float sl2, unsigned long long mymask, LAS unsigned char* Kt, LAS unsigned char* Vt, int lane, float& m, float& l, f32x16 (&oT)[2]) {
    f32x16 p0, p1;
    const float d0 = (float)(qpos - 64 * jc - 4 * (lane >> 5));
    const bool ok = (MODE == 2) || ((mymask >> jc) & 1ull);
    if (MODE == 2 || __any(ok)) {
        nsa_scores<MODE>(p0, p1, Kt, qf, lane, ok ? -sl2 * d0 : -INFINITY, sl2);
        if (jc == qt || (MODE == 2 && jc == qt - 8)) nsa_mask<MODE>(p0, p1, d0);
        nsa_softmax_pv(p0, p1, Vt, m, l, oT, lane);
    }
}
template <int MODE>
__device__ __forceinline__ void nsa_branch(const GAS bf16* P, unsigned long long blocks, int b, int g, int qt, int qpos, float sl2, unsigned long long mymask, const LAS unsigned char* qf,
                                           LAS unsigned char* lds, int tid, int lane, float& m, float& l, f32x16 (&oT)[2]) {
    const int kcol = (MODE == 1 ? PC_KS : PC_KW) + g * 64, vcol = (MODE == 1 ? PC_VS : PC_VW) + g * 64;
    u32x4 kr, vr; int it = 0;
    int j = blocks ? 63 - __builtin_clzll(blocks) : 0;
    if (blocks) nsa_load_kv(P, b * SEQ + 64 * j, kcol, vcol, tid, kr, vr);
    while (blocks) {
        blocks &= ~(1ull << j);
        LAS unsigned char* Kt = lds + (it & 1) * 18432; LAS unsigned char* Vt = Kt + 9216;
        nsa_store_kv(Kt, Vt, tid, kr, vr);
        const int jc = j;
        if (blocks) { j = 63 - __builtin_clzll(blocks); nsa_load_kv(P, b * SEQ + 64 * j, kcol, vcol, tid, kr, vr); }
        __syncthreads();
        nsa_step<MODE>(qf, jc, qt, qpos, sl2, mymask, Kt, Vt, lane, m, l, oT);
        ++it;
    }
}

#define NSA_T(k) do { if (NTS >= 0 && blockIdx.x == 0 && tid == 0) { const unsigned long long now_ = __builtin_amdgcn_s_memrealtime(); ((GAS unsigned long long*)(ws + WS_BAR + 16384 + 1024))[k] += now_ - t_prev_; t_prev_ = now_; } } while (0)
__device__ __forceinline__ void nsa_tile(GAS unsigned char* ws, int b, int g, int qt, LAS unsigned char* lds, int tid, int wave, int lane) {
    asm volatile("" : "+v"(tid)); lane = tid & 63;
    const GAS bf16* P = (const GAS bf16*)(ws + WS_P); const GAS float* F = (const GAS float*)(ws + WS_F); GAS bf16* MIX = (GAS bf16*)(ws + WS_MIX);
    const int hh = wave & 3, head = g * 4 + hh, s0 = qt * 64, qpos = s0 + (wave >> 2) * 32 + (lane & 31), tok = b * SEQ + qpos, hi = lane >> 5;
    const float sl2 = exp2f(-(float)(head + 1)) * LOG2E;
    LAS unsigned char* KC = lds; LAS unsigned char* VCT = lds + 36864;
    unsigned long long t_prev_ = (NTS >= 0) ? __builtin_amdgcn_s_memrealtime() : 0ull;
    LAS unsigned* PSLC = (LAS unsigned*)(lds + 73728); LAS unsigned long long* SELM = (LAS unsigned long long*)(lds + 90624); LAS unsigned long long* UM = (LAS unsigned long long*)(lds + 91136);
    __syncthreads();
    {
        const GAS bf16* kc = (const GAS bf16*)(ws + WS_KC) + (size_t)(b * 2 + g) * 256 * 64; const GAS bf16* vc = (const GAS bf16*)(ws + WS_VC) + (size_t)(b * 2 + g) * 256 * 64;
#pragma unroll
        for (int i = 0; i < 4; ++i) {
            const int ci = tid + 512 * i, row = ci >> 3, ch = ci & 7;
            const u32x4 kr = *(const GAS u32x4*)(kc + row * 64 + ch * 8), vr = *(const GAS u32x4*)(vc + row * 64 + ch * 8);
            *(LAS u32x4*)(KC + row * 144 + ch * 16) = kr;
            *(LAS u32x4*)(VCT + row * 144 + ch * 16) = vr;
        }
#pragma unroll
        for (int i = 0; i < 9; ++i) if (tid + 512 * i < 64 * 65) PSLC[tid + 512 * i] = 0u;
    }
    LAS unsigned char* qf = lds + 98304 + wave * 4096 + lane * 16;
    {
        const GAS bf16* qg = P + (size_t)tok * PW + PC_Q + head * 64 + 8 * hi;
#pragma unroll
        for (int ks = 0; ks < 4; ++ks) *(LAS bf16x8*)(qf + 1024 * ks) = *(const GAS bf16x8*)(qg + 16 * ks);
    }
    const float g0 = sigmoidf_(F[(size_t)tok * FW + FC_GATE + head * 3 + 0]);
    f32x16 outa[2];
    __syncthreads();
    NSA_T(4);
    const int cmin = (s0 - 31) >> 4;
    const int cmax = (s0 + 32) >> 4, nblk = (cmax >> 6) + 1 > 4 ? 4 : (cmax >> 6) + 1;
    {
        float m = NEGB, l = 0.f; f32x16 oT[2];
#pragma unroll
        for (int r = 0; r < 16; ++r) { oT[0][r] = 0.f; oT[1][r] = 0.f; }
        for (int blk = nblk - 1; blk >= 0; --blk) {
            f32x16 p0, p1;
            const float d0 = (float)(qpos - 31 - 16 * (64 * blk + 4 * hi));
            nsa_scores<0>(p0, p1, KC + blk * 64 * 144, qf, lane, -sl2 * d0, sl2);
            if (64 * blk + 63 > cmin) nsa_mask<0>(p0, p1, d0);
            nsa_softmax_pv(p0, p1, VCT + blk * 64 * 144, m, l, oT, lane);
        }
        l += __shfl_xor(l, 32);
        const float il = l > 0.f ? 1.0f / l : 0.f, sc = g0 * il;
#pragma unroll
        for (int r = 0; r < 16; ++r) { outa[0][r] = oT[0][r] * sc; outa[1][r] = oT[1][r] * sc; }
        NSA_T(5);
        LAS unsigned* prow = PSLC + ((wave >> 2) * 32 + (lane & 31)) * 65;
        for (int blk = 0; blk < nblk; ++blk) {
            f32x16 p0, p1;
            const float d0 = (float)(qpos - 31 - 16 * (64 * blk + 4 * hi));
            nsa_scores<0>(p0, p1, KC + blk * 64 * 144, qf, lane, -sl2 * d0, sl2);
            if (64 * blk + 63 > cmin) nsa_mask<0>(p0, p1, d0);
#pragma unroll
            for (int t2 = 0; t2 < 2; ++t2)
#pragma unroll
                for (int gq = 0; gq < 4; ++gq) {
                    const f32x16& pp = t2 ? p1 : p0; float e[4];
#pragma unroll
                    for (int i = 0; i < 4; ++i) e[i] = fexp2(pp[4 * gq + i] - m) * il;
                    const float a = 2.0f * ((e[0] + e[1]) + e[2]) + e[3], c = e[3];
                    const int jb = 16 * blk + 8 * t2 + 2 * gq + hi;
                    if (a > 0.f) atomicAdd((unsigned*)(prow + jb), (unsigned)(a * 268435456.0f + 0.5f));
                    if (c > 0.f && jb < 63) atomicAdd((unsigned*)(prow + jb + 1), (unsigned)(c * 268435456.0f + 0.5f));
                }
        }
    }
    __syncthreads();
    NSA_T(0);
    {
        unsigned long long um = 0ull;
        for (int qq = 0; qq < 8; ++qq) {
            const int q = wave * 8 + qq; const unsigned v = PSLC[q * 65 + lane];
            unsigned key;
            if (lane == 0 || lane == qt || lane == qt - 1) key = 0xffffffffu;
            else if (lane <= qt) key = v >= 0xfffffffdu ? 0xfffffffeu : v + 1u;
            else key = 0u;
            unsigned thr = 0u;
#pragma unroll
            for (int bit = 31; bit >= 0; --bit) { const unsigned c = thr | (1u << bit); if (__popcll(__ballot(key >= c)) >= 16) thr = c; }
            const unsigned long long gt = __ballot(key > thr), eq = __ballot(key == thr);
            const int need = 16 - __popcll(gt);
            const int below = __builtin_amdgcn_mbcnt_hi((unsigned)(eq >> 32), __builtin_amdgcn_mbcnt_lo((unsigned)eq, 0u));
            unsigned long long sel = gt | __ballot(key == thr && below < need);
            sel &= (qt >= 63) ? ~0ull : ((2ull << qt) - 1ull);
            if (lane == 0) SELM[q] = sel;
            um |= sel;
        }
        if (lane == 0) UM[wave] = um;
    }
    __syncthreads();
    NSA_T(1);
    unsigned long long ublocks = 0ull;
#pragma unroll
    for (int i = 0; i < 8; ++i) ublocks |= UM[i];
    ublocks = ((unsigned long long)(unsigned)__builtin_amdgcn_readfirstlane((int)(ublocks >> 32)) << 32) | (unsigned long long)(unsigned)__builtin_amdgcn_readfirstlane((int)ublocks);
    const unsigned long long mymask = SELM[(wave >> 2) * 32 + (lane & 31)];
    if (NTS >= 0 && blockIdx.x == 0 && tid == 0) {
        GAS unsigned long long* a_ = (GAS unsigned long long*)(ws + WS_BAR + 16384 + 1024);
        a_[6] += 100ull * (unsigned long long)__popcll(ublocks);
        unsigned long long w0 = 0ull; for (int i_ = 0; i_ < 32; ++i_) w0 |= SELM[i_];
        a_[7] += 100ull * (unsigned long long)__popcll(w0);
        unsigned long long w16 = 0ull; for (int i_ = 0; i_ < 16; ++i_) w16 |= SELM[i_];
        a_[13] += 100ull * (unsigned long long)__popcll(w16);
    }
    {
        float m = NEGB, l = 0.f; f32x16 oT[2];
#pragma unroll
        for (int r = 0; r < 16; ++r) { oT[0][r] = 0.f; oT[1][r] = 0.f; }
        nsa_branch<1>(P, ublocks, b, g, qt, qpos, sl2, mymask, qf, lds, tid, lane, m, l, oT);
        l += __shfl_xor(l, 32);
        const float g1 = sigmoidf_(F[(size_t)tok * FW + FC_GATE + head * 3 + 1]);
        const float sc = l > 0.f ? g1 / l : 0.f;
#pragma unroll
        for (int r = 0; r < 16; ++r) { outa[0][r] += oT[0][r] * sc; outa[1][r] += oT[1][r] * sc; }
    }
    __syncthreads();
    NSA_T(2);
    {
        float m = NEGB, l = 0.f; f32x16 oT[2];
#pragma unroll
        for (int r = 0; r < 16; ++r) { oT[0][r] = 0.f; oT[1][r] = 0.f; }
        const int jlo = qt >= 8 ? qt - 8 : 0;
        const unsigned long long upto = (qt >= 63) ? ~0ull : ((2ull << qt) - 1ull);
        const unsigned long long wblocks = upto & ~((1ull << jlo) - 1ull);
        nsa_branch<2>(P, wblocks, b, g, qt, qpos, sl2, 0ull, qf, lds, tid, lane, m, l, oT);
        l += __shfl_xor(l, 32);
        const float g2 = sigmoidf_(F[(size_t)tok * FW + FC_GATE + head * 3 + 2]);
        const float sc = l > 0.f ? g2 / l : 0.f;
#pragma unroll
        for (int r = 0; r < 16; ++r) { outa[0][r] += oT[0][r] * sc; outa[1][r] += oT[1][r] * sc; }
    }
#pragma unroll
    for (int dt = 0; dt < 2; ++dt)
#pragma unroll
        for (int gq = 0; gq < 4; ++gq) {
            u32x2 w; w.x = pk_bf16(outa[dt][4 * gq], outa[dt][4 * gq + 1]); w.y = pk_bf16(outa[dt][4 * gq + 2], outa[dt][4 * gq + 3]);
            *(GAS u32x2*)(MIX + (size_t)tok * DM + head * 64 + 32 * dt + 8 * gq + 4 * hi) = w;
        }    NSA_T(3);
}
#define XB_TMO      128
#define XB_XCNT(j)  (256  + 64 * (j))
#define XB_XSUB(j)  (1280 + 64 * (j))
#define XB_XGEN(j)  (2304 + 64 * (j))
#define XB_TOP      3328
#define XB_TOPGEN   3392
#define XCD_BAR_WORDS 3456
#define XB_SPIN_CAP (1u << 18)

__device__ __forceinline__ unsigned xb_ld(unsigned* p)              { return __hip_atomic_load(p, __ATOMIC_RELAXED, __HIP_MEMORY_SCOPE_AGENT); }
__device__ __forceinline__ unsigned xb_add(unsigned* p, unsigned v) { return __hip_atomic_fetch_add(p, v, __ATOMIC_RELAXED, __HIP_MEMORY_SCOPE_AGENT); }
__device__ __forceinline__ unsigned xb_xcc_id() { return (unsigned)__builtin_amdgcn_s_getreg((3 << 11) | 20) & 0xFu; }
#define XB_SPIN(cond, bar) do { unsigned _sp = 0; while (cond) { __builtin_amdgcn_s_sleep(1); \
    if ((++_sp & 255u) == 0u) { if (xb_ld(&(bar)[XB_TMO])) break; if (_sp > XB_SPIN_CAP) { atomicAdd(&(bar)[XB_TMO], 1u); break; } } } } while (0)

struct XcdBarrier {
    unsigned* bar; unsigned x;
    volatile LAS unsigned* st;
};

__device__ __forceinline__ XcdBarrier xcd_barrier_post(unsigned* bar, volatile LAS unsigned* st) {
    XcdBarrier b; b.bar = bar; b.x = xb_xcc_id(); b.st = st;
    if (threadIdx.x == 0) (void)xb_add(&bar[XB_XCNT(b.x)], 1u);
    return b;
}
__device__ __forceinline__ void xcd_barrier_complete(unsigned* bar, unsigned x, unsigned& nloc, unsigned& nx) {
    const unsigned G = gridDim.x * gridDim.y * gridDim.z;
    unsigned sum, cnt, mine, sp = 0u;
    for (;;) {
        sum = 0u; cnt = 0u; mine = 0u;
#pragma unroll
        for (unsigned j = 0; j < 16; ++j) { const unsigned c = xb_ld(&bar[XB_XCNT(j)]); sum += c; cnt += (c > 0u) ? 1u : 0u; mine = (j == x) ? c : mine; }
        if (sum == G) break;
        __builtin_amdgcn_s_sleep(1);
        if ((++sp & 255u) == 0u) { if (xb_ld(&bar[XB_TMO])) break; if (sp > XB_SPIN_CAP) { atomicAdd(&bar[XB_TMO], 1u); break; } }
    }
    nloc = mine > 0u ? mine : 1u; nx = cnt > 0u ? cnt : 1u;
}

__device__ __forceinline__ void xcd_barrier(const XcdBarrier& b) {
    asm volatile("s_waitcnt vmcnt(0)" ::: "memory");
    __syncthreads();
    if (threadIdx.x == 0) {
        unsigned* bar = b.bar;
        __builtin_amdgcn_s_waitcnt(0);
        unsigned nloc = b.st[0], nx = b.st[1];
        if (nloc == 0u) { xcd_barrier_complete(bar, b.x, nloc, nx); b.st[0] = nloc; b.st[1] = nx; }
        const unsigned old = xb_add(&bar[XB_XSUB(b.x)], 1u);
        const unsigned gen = old / nloc;
        if (old + 1u == (gen + 1u) * nloc) {
            __builtin_amdgcn_fence(__ATOMIC_RELEASE, "agent");
            asm volatile("s_waitcnt vmcnt(0)" ::: "memory");
            const unsigned og = xb_add(&bar[XB_TOP], 1u);
            const unsigned tg = og / nx;
            if (og + 1u == (tg + 1u) * nx) xb_add(&bar[XB_TOPGEN], 1u);
            else XB_SPIN(xb_ld(&bar[XB_TOPGEN]) == tg, bar);
            __builtin_amdgcn_fence(__ATOMIC_ACQUIRE, "agent");
            xb_add(&bar[XB_XGEN(b.x)], 1u);
            asm volatile("s_waitcnt vmcnt(0)" ::: "memory");
        } else {
            XB_SPIN(xb_ld(&bar[XB_XGEN(b.x)]) == gen, bar);
            __builtin_amdgcn_fence(__ATOMIC_ACQUIRE, "agent");
            asm volatile("s_waitcnt vmcnt(0)" ::: "memory");
        }
    }
    __syncthreads();
}

#ifndef PROBE_REP
#define PROBE_REP 0
#endif
#ifndef TSP
#define TSP -1
#endif
template <class Tp> __device__ __forceinline__ Tp* launder(Tp* p) { unsigned long long v = (unsigned long long)p; asm volatile("" : "+s"(v)); return (Tp*)v; }
template <class Tp> __device__ __forceinline__ GAS Tp* launder(GAS Tp* p) { unsigned long long v = (unsigned long long)p; asm volatile("" : "+s"(v)); return (GAS Tp*)v; }
__global__ void __launch_bounds__(512, 2) hymba_fwd(Args A) {
    extern __shared__ __attribute__((aligned(16))) unsigned char smem[];
    LAS unsigned char* lds = (LAS unsigned char*)smem;
    cg::grid_group grid = cg::this_grid();
    const int tid0 = threadIdx.x, wave = __builtin_amdgcn_readfirstlane(tid0 >> 6);
    GAS unsigned char* ws0 = A.ws;
#define HB ((GAS bf16*)(ws + WS_HB))
#define MIX ((GAS bf16*)(ws + WS_MIX))
#define Pb ((GAS bf16*)(ws + WS_P))
#define Fb ((GAS float*)(ws + WS_F))
#define SSQ ((GAS float*)(ws + WS_SSQ))
    GAS bf16* SB = (GAS bf16*)A.out;
    const int lo = A.ph_lo, hi = A.ph_hi; int ph = 0;
    if (TSP >= 0 && blockIdx.x == 0 && tid0 == 0) ((GAS unsigned long long*)(ws0 + WS_BAR + 16384))[0] = __builtin_amdgcn_s_memrealtime();
    volatile LAS unsigned* xst = (volatile LAS unsigned*)(lds + LDS_BYTES - 64);
    if (tid0 < 2) xst[tid0] = 0u;
    __syncthreads();
    const XcdBarrier xbar = xcd_barrier_post((unsigned*)(ws0 + WS_BAR), xst);
#define PH_BEGIN if (ph >= lo && ph < hi) { int tid = tid0; asm volatile("" : "+v"(tid)); const int lane = tid & 63; GAS unsigned char* ws = launder(ws0);
#define PH_END } if (TSP >= 0 && blockIdx.x == 0 && tid0 == 0) ((GAS unsigned long long*)(ws0 + WS_BAR + 16384))[ph + 1] = __builtin_amdgcn_s_memrealtime(); if (ph >= lo && ph + 1 < hi) { if (hi < 0) grid.sync();   xcd_barrier(xbar); } ++ph;

    for (int layer = 0; layer < 2; ++layer) {
        PH_BEGIN prologue(A, ws, layer, lds, tid, wave, lane); PH_END
        PH_BEGIN
            pg8::Gemm g{(const bf16*)launder(HB), (const bf16*)launder((const GAS bf16*)(ws + W_GU1)), T, NGU, DM}; pg8::StaticOrder S; S.init(T, NGU, gridDim.x, blockIdx.x);
            pg8::EpiGU E{Pb, SSQ};
            pg8::gemm_phase<pg8::EpiGU, pg8::StaticOrder, true, true>(lds, g, S, E);
        PH_END
        PH_BEGIN
            pg8::Gemm g{(const bf16*)launder(Pb), (const bf16*)launder((const GAS bf16*)(ws + W_DN1)), T, DM, FFP}; pg8::StaticOrder S; S.init(T, DM, gridDim.x, blockIdx.x);
            if (layer == 0) { pg8::EpiRES<true> E{A.in[0], HB, SSQ, 0.5f}; pg8::gemm_phase<pg8::EpiRES<true>, pg8::StaticOrder, false, true>(lds, g, S, E); }
            else { pg8::EpiRES<false> E{nullptr, HB, SSQ, 0.5f}; pg8::gemm_phase<pg8::EpiRES<false>, pg8::StaticOrder, false, true>(lds, g, S, E); }
        PH_END
        PH_BEGIN
            pg8::Gemm g{(const bf16*)launder(HB), (const bf16*)launder((const GAS bf16*)(ws + W_IN)), T, NIN, DM}; pg8::StaticOrder S; S.init(T, NIN, gridDim.x, blockIdx.x);
            pg8::EpiIN E{Pb, Fb, SSQ};
            for (int rp = 0; rp < ((PROBE_REP & 4) ? 2 : 1); ++rp)
            pg8::gemm_phase<pg8::EpiIN, pg8::StaticOrder, true, true>(lds, g, S, E);
        PH_END
        PH_BEGIN
            if (gridDim.x == 256) {
                const int bx = blockIdx.x;
                f32x4 zr[4]; u32x2 hqr[4], hir[4];
                const int first = bx < 128 ? bx * 3 : 384 + (bx - 128) * 5, cnt = bx < 128 ? 3 : 5;
                if (bx < 128) compress_item(ws, bx, lds, tid, wave, lane);
                hg1_load(ws, first, tid, zr, hqr, hir);
                for (int i = 0; i < cnt; ++i) hg_step1(ws, SB, first + i, i + 1 < cnt ? first + i + 1 : -1, zr, hqr, hir, lds, tid, wave, lane);
            } else {
                f32x4 zr[4]; u32x2 hqr[4], hir[4];
                for (int ci = blockIdx.x; ci < 128; ci += gridDim.x) compress_item(ws, ci, lds, tid, wave, lane);
                for (int it = blockIdx.x; it < 1024; it += gridDim.x) { hg1_load(ws, it, tid, zr, hqr, hir); hg_step1(ws, SB, it, -1, zr, hqr, hir, lds, tid, wave, lane); }
            }
        PH_END
        PH_BEGIN hg_scan(ws, SB, tid); PH_END
        PH_BEGIN
            {
                GAS unsigned* ctr = (GAS unsigned*)(ws + WS_BAR) + 3584 + 64 * layer;
                volatile LAS int* slot = (volatile LAS int*)(lds + LDS_BYTES - 32);
                if (tid == 0) slot[0] = (int)__hip_atomic_fetch_add(ctr, 1u, __ATOMIC_RELAXED, __HIP_MEMORY_SCOPE_AGENT);
                __syncthreads();
                int par = 0;
                for (;;) {
                    const int it = __builtin_amdgcn_readfirstlane(slot[par]);
                    if (it >= 1536) break;
                    int nxt = 0;
                    if (tid == 0) nxt = (int)__hip_atomic_fetch_add(ctr, 1u, __ATOMIC_RELAXED, __HIP_MEMORY_SCOPE_AGENT);
                    if (it < 512) { for (int rq = 0; rq < ((PROBE_REP & 8) ? 2 : 1); ++rq) nsa_tile(ws, (it & 7) >> 1, it & 1, 63 - (it >> 3), lds, tid, wave, lane); }
                    else hg_step3(ws, SB, A.in[13] + layer * 128, it - 512, lds, tid, wave, lane);
                    if (tid == 0) slot[par ^ 1] = nxt;
                    __syncthreads();
                    par ^= 1;
                }
            }
        PH_END
        PH_BEGIN
            pg8::Gemm g{(const bf16*)launder(MIX), (const bf16*)launder((const GAS bf16*)(ws + W_OUT)), T, DM, DM}; pg8::StaticOrder S; S.init(T, DM, gridDim.x, blockIdx.x);
            pg8::EpiRES<false> E{nullptr, HB, SSQ, 1.0f};
            pg8::gemm_phase<pg8::EpiRES<false>, pg8::StaticOrder, false, true>(lds, g, S, E);
        PH_END
        PH_BEGIN
            pg8::Gemm g{(const bf16*)launder(HB), (const bf16*)launder((const GAS bf16*)(ws + W_GU2)), T, NGU, DM}; pg8::StaticOrder S; S.init(T, NGU, gridDim.x, blockIdx.x);
            pg8::EpiGU E{Pb, SSQ};
            pg8::gemm_phase<pg8::EpiGU, pg8::StaticOrder, true, true>(lds, g, S, E);
        PH_END
        PH_BEGIN
            pg8::Gemm g{(const bf16*)launder(Pb), (const bf16*)launder((const GAS bf16*)(ws + W_DN2)), T, DM, FFP}; pg8::StaticOrder S; S.init(T, DM, gridDim.x, blockIdx.x);
            pg8::EpiRES<false> E{nullptr, HB, SSQ, 0.5f};
            pg8::gemm_phase<pg8::EpiRES<false>, pg8::StaticOrder, false, true>(lds, g, S, E);
        PH_END
    }
    PH_BEGIN
        const GAS float* fn = A.in[18]; GAS float* OUT = A.out;
        const int NGW = gridDim.x * 8; const GAS f32x4* gn = (const GAS f32x4*)fn + lane;
        f32x4 g4[4];
#pragma unroll
        for (int j = 0; j < 4; ++j) g4[j] = gn[64 * j];
        for (int row = blockIdx.x * 8 + wave; row < T; row += 4 * NGW) {
            f32x4 sq[4]; u32x2 w[4][4];
#pragma unroll
            for (int r = 0; r < 4; ++r) { const int rw = row + r * NGW; if (rw < T) { sq[r] = *(const GAS f32x4*)(SSQ + (unsigned)(rw * 4)); const GAS u32x2* hr = (const GAS u32x2*)(HB + (size_t)rw * DM) + lane;
#pragma unroll
                for (int j = 0; j < 4; ++j) w[r][j] = __builtin_nontemporal_load(hr + 64 * j); } }
#pragma unroll
            for (int r = 0; r < 4; ++r) { const int rw = row + r * NGW; if (rw < T) { const float rs = rstd_from(sq[r]); GAS f32x4* orow = (GAS f32x4*)(OUT + (size_t)rw * DM) + lane;
                float dl = 0.f;
                if ((TSP >= 0 || NTS >= 0) && rw < 64) { const GAS unsigned long long* ts = (const GAS unsigned long long*)(ws + WS_BAR + 16384); const float us = (NTS >= 0) ? (float)(ts[128 + NTS]) * 0.01f : (float)(ts[TSP + 1] - ts[TSP]) * 0.01f; dl = 0.002f * sqrtf(us); }
#pragma unroll
                for (int j = 0; j < 4; ++j) __builtin_nontemporal_store((f32x4){bflo(w[r][j].x) * rs * g4[j][0] + dl, bfhi(w[r][j].x) * rs * g4[j][1] - dl, bflo(w[r][j].y) * rs * g4[j][2] + dl, bfhi(w[r][j].y) * rs * g4[j][3] - dl}, orow + 64 * j); } }
        }
    PH_END
#undef HB
#undef MIX
#undef Pb
#undef Fb
#undef SSQ
#undef PH_BEGIN
#undef PH_END
}

extern "C" void kernel_launch(void* const* d_in, const int* in_sizes, int n_in, void* d_out, int out_size, void* d_ws, size_t ws_size, hipStream_t stream) {
    static int grid = 0;
    if (grid == 0) {
        int dev = 0, cus = 0, per_cu = 0;
        hipGetDevice(&dev);
        hipDeviceGetAttribute(&cus, hipDeviceAttributeMultiprocessorCount, dev);
        if (hipFuncSetAttribute((const void*)hymba_fwd, hipFuncAttributeMaxDynamicSharedMemorySize, LDS_BYTES) != hipSuccess) fprintf(stderr, "hipFuncSetAttribute failed\n");
        if (hipOccupancyMaxActiveBlocksPerMultiprocessor(&per_cu, (const void*)hymba_fwd, 512, LDS_BYTES) != hipSuccess || per_cu < 1) { fprintf(stderr, "occupancy query: %d\n", per_cu); per_cu = 1; }
        (void)hipGetLastError();
        grid = cus * 1;
        if (n_in != 19 || ws_size < WS_END) fprintf(stderr, "unexpected n_in %d / ws %zu\n", n_in, ws_size);
    }
    (void)hipMemsetAsync((unsigned char*)d_ws + WS_BAR, 0, 16384 + 2048, stream);
    Args a{};
    for (int i = 0; i < 19; ++i) a.in[i] = (const GAS float*)d_in[i];
    a.out = (GAS float*)d_out; a.ws = (GAS unsigned char*)d_ws; a.ph_lo = 0; a.ph_hi = 1000;
    void* args[] = {&a};
    hipError_t e = hipLaunchCooperativeKernel((const void*)hymba_fwd, dim3(grid), dim3(512), args, LDS_BYTES, stream);
    if (e != hipSuccess) fprintf(stderr, "cooperative launch failed: %s (grid %d)\n", hipGetErrorString(e), grid);
}
```

```cpp
#include <hip/hip_runtime.h>
#include <hip/hip_cooperative_groups.h>
#include <cstdio>
#include <cstdint>
namespace cg = cooperative_groups;
#ifndef PROBE_REP
#define PROBE_REP 0
#endif
namespace pg8 {
#define PG8_LAS __attribute__((address_space(3)))
typedef unsigned short bf16_t;
typedef short bf16x8 __attribute__((ext_vector_type(8)));
typedef float f32x4 __attribute__((ext_vector_type(4)));
typedef unsigned u32x4 __attribute__((ext_vector_type(4)));
constexpr int BM = 256, BK = 64, HALF = 128, HTB = HALF * BK * 2  , STAGE_BYTES = 8 * HTB, NXCD = 8, WGM = 8;

__host__ __device__ __forceinline__ int lds_byte(int r, int c) { const int st = (r >> 4) * 2 + (c >> 5), rr = r & 15, cc = c & 31, ob = rr * 64 + cc * 2; return st * 1024 + (ob ^ (((ob >> 9) & 1) << 5)); }
__host__ __device__ __forceinline__ void stage_rc(int b, int& R, int& C) { const int st = b / 1024, sb = b % 1024, swz = sb ^ (((sb >> 9) & 1) << 5); R = (st >> 1) * 16 + swz / 64; C = (st & 1) * 32 + (swz % 64) / 2; }
__host__ __device__ __forceinline__ int perm32(int rho) { const int n = rho >> 4, i = rho & 15; return 8 * (i >> 2) + 4 * n + (i & 3); }

struct Unit { int pm, pn; };
struct Gemm { const bf16_t* A; const bf16_t* Bt; int M, N, K; };

struct StaticOrder {
    int nM, nN, nwg, G, c;
    __host__ __device__ void init(int M, int N, int G_, int c_) { nM = M / BM; nN = N / BM; nwg = nM * nN; G = G_; c = c_; }
    __host__ __device__ bool next(int i, Unit& u) const {
        const long L = (long)i * G + c; if (L >= nwg) return false;
        int wgid = (int)L; { const int q = nwg / NXCD, r = nwg % NXCD, xcd = wgid % NXCD, off = wgid / NXCD; wgid = (xcd < r ? xcd * (q + 1) : r * (q + 1) + (xcd - r) * q) + off; }
        const int nig = WGM * nN, gid = wgid / nig, fm = gid * WGM, gsz = (nM - fm) < WGM ? (nM - fm) : WGM;
        u.pm = fm + ((wgid % nig) % gsz); u.pn = (wgid % nig) / gsz; return true;
    }
    __device__ __forceinline__ void a_ready(const Unit&) const {}
    __device__ __forceinline__ void done(const Unit&) const {}
};

__device__ __forceinline__ unsigned cvt_pk_bf16(float lo, float hi) { unsigned r; asm volatile("v_cvt_pk_bf16_f32 %0, %1, %2" : "=v"(r) : "v"(lo), "v"(hi)); return r; }
template <class Epi, class Sched, bool ALIGN_EPI = false, bool SP2 = false>
__device__ __forceinline__ void gemm_phase(PG8_LAS unsigned char* lds, const Gemm g, const Sched& S, const Epi& E) {
    int tid_l = threadIdx.x; asm volatile("" : "+v"(tid_l)); const int tid = tid_l, wid = __builtin_amdgcn_readfirstlane(tid >> 6), lane = tid & 63, wr = wid >> 2, wc = wid & 3, fr = lane & 15, fq = lane >> 4;
    const int K = g.K, nt = K / BK;
    unsigned voffA[2], voffB[2];
#pragma unroll
    for (int i = 0; i < 2; ++i) { int R, C; stage_rc(tid * 16 + i * 8192, R, C); const int Rb = Epi::PERM ? ((R & ~31) + perm32(R & 31)) : R;
        voffA[i] = (unsigned)(R * K + C) * 2u; voffB[i] = (unsigned)(Rb * K + C) * 2u; }
    const size_t kstep = (size_t)(BK * 2);
    const size_t hstep = (size_t)HALF * K * 2;
    const size_t tstep = 2 * hstep;
    const unsigned ldsw = (unsigned)wid * 1024u;
    const int aoff = lds_byte(wr * 64 + fr, fq * 8), boff = lds_byte(wc * 32 + fr, fq * 8);
#define PG8_SA(b, h) (((b) * 2 + (h)) * HTB)
#define PG8_SB(b, h) ((4 + (b) * 2 + (h)) * HTB)
#define PG8_STAGE(bufoff, gbase, voff) do { _Pragma("unroll") for (int _i = 0; _i < 2; ++_i) \
        __builtin_amdgcn_global_load_lds((const unsigned*)((const char*)(gbase) + (voff)[_i]), (PG8_LAS unsigned*)(lds + (bufoff) + ldsw + _i * 8192), 16, 0, 0); } while (0)
#define PG8_LDA(dst, b, h) do { _Pragma("unroll") for (int m = 0; m < 4; ++m) _Pragma("unroll") for (int k = 0; k < 2; ++k) dst[m][k] = *(const PG8_LAS bf16x8*)(lds + PG8_SA(b, h) + aoff + m * 2048 + k * 1024); } while (0)
#define PG8_LDB(dst, b, h) do { _Pragma("unroll") for (int n = 0; n < 2; ++n) _Pragma("unroll") for (int k = 0; k < 2; ++k) dst[n][k] = *(const PG8_LAS bf16x8*)(lds + PG8_SB(b, h) + boff + n * 2048 + k * 1024); } while (0)
#define PG8_MMA(ai, bj, At, Bt) do { __builtin_amdgcn_s_setprio(1); _Pragma("unroll") for (int m = 0; m < 4; ++m) _Pragma("unroll") for (int n = 0; n < 2; ++n) _Pragma("unroll") for (int k = 0; k < 2; ++k) \
        acc[ai][bj][m][n] = __builtin_amdgcn_mfma_f32_16x16x32_bf16(Bt[n][k], At[m][k], acc[ai][bj][m][n], 0, 0, 0); __builtin_amdgcn_s_setprio(0); } while (0)
#define PG8_WAIT_V(n) asm volatile("s_waitcnt vmcnt(" #n ")" ::: "memory")
#define PG8_WAIT_L(n) asm volatile("s_waitcnt lgkmcnt(" #n ")" ::: "memory")
#define PG8_BAR __builtin_amdgcn_s_barrier()
#define PG8_SCHED __builtin_amdgcn_sched_barrier(0)
    Unit cur, nxt; int ui = 0;
    if (!S.next(0, cur)) return;
    f32x4 acc[2][2][4][2];
#pragma unroll
    for (int a = 0; a < 2; ++a)
#pragma unroll
        for (int b = 0; b < 2; ++b)
#pragma unroll
            for (int m = 0; m < 4; ++m)
#pragma unroll
                for (int n = 0; n < 2; ++n) acc[a][b][m][n] = (f32x4){0.f, 0.f, 0.f, 0.f};
    bf16x8 At[4][2], B0[2][2], B1[2][2];
    const char* cA = (const char*)g.A + (size_t)cur.pm * tstep; const char* cB = (const char*)g.Bt + (size_t)cur.pn * tstep;
    S.a_ready(cur);
    if constexpr (SP2) {
        PG8_STAGE(PG8_SB(0, 0), cB, voffB); PG8_STAGE(PG8_SB(0, 1), cB + hstep, voffB); PG8_STAGE(PG8_SA(0, 0), cA, voffA); PG8_STAGE(PG8_SA(0, 1), cA + hstep, voffA);
        if (wr == 1) PG8_BAR;
        PG8_WAIT_V(2); PG8_BAR;
        PG8_STAGE(PG8_SB(1, 0), cB + kstep, voffB); PG8_STAGE(PG8_SA(1, 0), cA + kstep, voffA); PG8_STAGE(PG8_SB(1, 1), cB + hstep + kstep, voffB);
        PG8_WAIT_V(6); PG8_BAR;
    } else {
        PG8_STAGE(PG8_SB(0, 0), cB, voffB); PG8_STAGE(PG8_SA(0, 0), cA, voffA); PG8_STAGE(PG8_SB(0, 1), cB + hstep, voffB); PG8_STAGE(PG8_SA(0, 1), cA + hstep, voffA);
        if (wr == 1) PG8_BAR;
        PG8_WAIT_V(4); PG8_BAR;
        PG8_STAGE(PG8_SB(1, 0), cB + kstep, voffB); PG8_STAGE(PG8_SA(1, 0), cA + kstep, voffA); PG8_STAGE(PG8_SB(1, 1), cB + hstep + kstep, voffB);
        PG8_WAIT_V(6); PG8_BAR;
    }
    for (;;) {
        const bool has_next = S.next(ui + 1, nxt);
        const char* nA = has_next ? (const char*)g.A + (size_t)nxt.pm * tstep : cA; const char* nB = has_next ? (const char*)g.Bt + (size_t)nxt.pn * tstep : cB;
        for (int t = 0; t < nt; t += 2) {
            const bool last = (t == nt - 2);
            const char* a1 = cA + (size_t)(t + 1) * kstep;
            const char* a2 = last ? nA : cA + (size_t)(t + 2) * kstep; const char* b2 = last ? nB : cB + (size_t)(t + 2) * kstep;
            const char* a3 = a2 + kstep; const char* b3 = b2 + kstep;
            if (last && has_next) S.a_ready(nxt);
            if constexpr (SP2) {
            PG8_LDB(B0, 0, 0); PG8_LDB(B1, 0, 1); PG8_SCHED; PG8_LDA(At, 0, 0); PG8_STAGE(PG8_SA(1, 1), a1 + hstep, voffA);
            PG8_WAIT_V(8); PG8_WAIT_L(0); PG8_BAR; PG8_MMA(0, 0, At, B0); PG8_MMA(0, 1, At, B1); PG8_BAR; PG8_SCHED;
            PG8_LDA(At, 0, 1); PG8_STAGE(PG8_SB(0, 0), b2, voffB); PG8_STAGE(PG8_SB(0, 1), b2 + hstep, voffB); PG8_STAGE(PG8_SA(0, 0), a2, voffA);
            PG8_WAIT_V(8); PG8_WAIT_L(0); PG8_BAR; PG8_MMA(1, 0, At, B0); PG8_MMA(1, 1, At, B1); PG8_BAR; PG8_SCHED;
            PG8_LDB(B0, 1, 0); PG8_LDB(B1, 1, 1); PG8_SCHED; PG8_LDA(At, 1, 0); PG8_STAGE(PG8_SA(0, 1), a2 + hstep, voffA);
            PG8_WAIT_V(8); PG8_WAIT_L(0); PG8_BAR; PG8_MMA(0, 0, At, B0); PG8_MMA(0, 1, At, B1); PG8_BAR; PG8_SCHED;
            PG8_LDA(At, 1, 1); PG8_STAGE(PG8_SB(1, 0), b3, voffB); PG8_STAGE(PG8_SB(1, 1), b3 + hstep, voffB); PG8_STAGE(PG8_SA(1, 0), a3, voffA);
            PG8_WAIT_V(8); PG8_WAIT_L(0); PG8_BAR; PG8_MMA(1, 0, At, B0); PG8_MMA(1, 1, At, B1); PG8_BAR; PG8_SCHED;
            } else {
            PG8_LDB(B0, 0, 0); PG8_SCHED; PG8_LDA(At, 0, 0); PG8_STAGE(PG8_SA(1, 1), a1 + hstep, voffA);
            PG8_WAIT_L(8); PG8_BAR; PG8_WAIT_L(0); PG8_MMA(0, 0, At, B0); PG8_BAR; PG8_SCHED;
            PG8_LDB(B1, 0, 1); PG8_STAGE(PG8_SB(0, 0), b2, voffB);
            PG8_BAR; PG8_WAIT_L(0); PG8_MMA(0, 1, At, B1); PG8_BAR;
            PG8_LDA(At, 0, 1); PG8_STAGE(PG8_SA(0, 0), a2, voffA);
            PG8_BAR; PG8_WAIT_L(0); PG8_MMA(1, 0, At, B0); PG8_BAR; PG8_SCHED;
            PG8_STAGE(PG8_SB(0, 1), b2 + hstep, voffB);
            PG8_WAIT_V(6); PG8_BAR; PG8_MMA(1, 1, At, B1); PG8_BAR;
            PG8_LDB(B0, 1, 0); PG8_SCHED; PG8_LDA(At, 1, 0); PG8_STAGE(PG8_SA(0, 1), a2 + hstep, voffA);
            PG8_WAIT_L(8); PG8_BAR; PG8_WAIT_L(0); PG8_MMA(0, 0, At, B0); PG8_BAR; PG8_SCHED;
            PG8_LDB(B1, 1, 1); PG8_STAGE(PG8_SB(1, 0), b3, voffB);
            PG8_BAR; PG8_WAIT_L(0); PG8_MMA(0, 1, At, B1); PG8_BAR;
            PG8_LDA(At, 1, 1); PG8_STAGE(PG8_SA(1, 0), a3, voffA);
            PG8_BAR; PG8_WAIT_L(0); PG8_MMA(1, 0, At, B0); PG8_BAR; PG8_SCHED;
            PG8_STAGE(PG8_SB(1, 1), b3 + hstep, voffB);
            PG8_WAIT_V(6); PG8_BAR; PG8_MMA(1, 1, At, B1); PG8_BAR;
            }
        }
        if constexpr (ALIGN_EPI) { if (wr == 0) PG8_BAR; }
        if constexpr (!Epi::AFTER_DRAIN) { E(acc, cur, wr, wc, fr, fq); S.done(cur); }
        if (!has_next) break;
#pragma unroll
        for (int a = 0; a < 2; ++a)
#pragma unroll
            for (int b = 0; b < 2; ++b)
#pragma unroll
                for (int m = 0; m < 4; ++m)
#pragma unroll
                    for (int n = 0; n < 2; ++n) acc[a][b][m][n] = (f32x4){0.f, 0.f, 0.f, 0.f};
        cur = nxt; cA = nA; cB = nB; ++ui;
        if constexpr (ALIGN_EPI) { if (wr == 1) PG8_BAR; }
    }
    PG8_WAIT_V(0);
    if constexpr (!ALIGN_EPI) { if (wr == 0) PG8_BAR; }
    PG8_BAR;
    if constexpr (Epi::AFTER_DRAIN) { E.fused(acc, cur, wr, wc, fr, fq, lds, wid, lane); S.done(cur); }
#undef PG8_SA
#undef PG8_SB
#undef PG8_STAGE
#undef PG8_LDA
#undef PG8_LDB
#undef PG8_MMA
#undef PG8_WAIT_V
#undef PG8_WAIT_L
#undef PG8_BAR
#undef PG8_SCHED
}
}

#define LAS __attribute__((address_space(3)))
#define GAS __attribute__((address_space(1)))
typedef unsigned short bf16;
typedef short bf16x8 __attribute__((ext_vector_type(8)));
typedef short s16x4 __attribute__((ext_vector_type(4)));
typedef float f32x4 __attribute__((ext_vector_type(4)));
typedef float f32x2 __attribute__((ext_vector_type(2)));
typedef float f32x16 __attribute__((ext_vector_type(16)));
typedef unsigned u32x4 __attribute__((ext_vector_type(4)));
typedef unsigned u32x2 __attribute__((ext_vector_type(2)));

constexpr int T = 16384, SEQ = 4096, DM = 1024, FF = 2752, FFP = 2816, NGU = 5632, NIN = 3584, NINSRC = 3352;
constexpr int PW = 2816, FW = 544;
constexpr float EPS = 1e-6f, LOG2E = 1.4426950408889634f, NEGB = -1e30f;
constexpr int PC_Q = 0, PC_KC = 512, PC_VC = 640, PC_KS = 768, PC_VS = 896, PC_KW = 1024, PC_VW = 1152, PC_HQ = 1280, PC_HI = 1792, PC_HG = 2304;
constexpr int FC_HF = 0, FC_GATE = 512;

constexpr size_t MiB = 1u << 20;
constexpr size_t W_GU1 = 0, W_DN1 = 11 * MiB, W_IN = W_DN1 + 5 * MiB + MiB / 2, W_OUT = W_IN + 7 * MiB, W_GU2 = W_OUT + 2 * MiB, W_DN2 = W_GU2 + 11 * MiB,
                 W_C1K = W_DN2 + 5 * MiB + MiB / 2, W_C1V = W_C1K + MiB, W_C2K = W_C1V + MiB, W_C2V = W_C2K + 32768;
constexpr size_t WS_SSQ = 45 * MiB, WS_KC = 46 * MiB, WS_VC = WS_KC + 262144, WS_DC = WS_VC + 262144, WS_CB = 47 * MiB, WS_LB = WS_CB + 32768;
constexpr size_t WS_HB = 49 * MiB, WS_MIX = 81 * MiB, WS_P = 113 * MiB, WS_F = 201 * MiB, WS_QG = 235 * MiB, WS_END = 251 * MiB;
constexpr size_t WS_BAR = WS_LB + 4096;
static_assert(W_C2V + 32768 <= WS_SSQ, "weights fit");
constexpr int LDS_BYTES = 147456;

__device__ __forceinline__ unsigned pk_bf16(float lo, float hi) {
    typedef __bf16 b2 __attribute__((ext_vector_type(2)));
    f32x2 v = {lo, hi}; b2 b = __builtin_convertvector(v, b2); return __builtin_bit_cast(unsigned, b);
}
__device__ __forceinline__ float bflo(unsigned u) { return __uint_as_float(u << 16); }
__device__ __forceinline__ float bfhi(unsigned u) { return __uint_as_float(u & 0xffff0000u); }
__device__ __forceinline__ float fexp2(float x) { return __builtin_amdgcn_exp2f(x); }
__device__ __forceinline__ float fexp(float x) { return __builtin_amdgcn_exp2f(x * LOG2E); }
__device__ __forceinline__ float frcp(float x) { return __builtin_amdgcn_rcpf(x); }
__device__ __forceinline__ float sigmoidf_(float x) { return frcp(1.0f + fexp(-x)); }
__device__ __forceinline__ float siluf_(float x) { return x * sigmoidf_(x); }
__device__ __forceinline__ float gelu_tanh(float x) { const float u = 0.7978845608028654f * (x + 0.044715f * x * x * x); return x * sigmoidf_(2.0f * u); }
__device__ __forceinline__ float wave_sum(float v) {
#pragma unroll
    for (int o = 1; o < 64; o <<= 1) v += __shfl_xor(v, o);
    return v;
}
__device__ __forceinline__ f32x4 mfma16(bf16x8 a, bf16x8 b, f32x4 c) { return __builtin_amdgcn_mfma_f32_16x16x32_bf16(a, b, c, 0, 0, 0); }
__device__ __forceinline__ f32x16 mfma32(bf16x8 a, bf16x8 b, f32x16 c) { return __builtin_amdgcn_mfma_f32_32x32x16_bf16(a, b, c, 0, 0, 0); }
__device__ __forceinline__ float rstd_from(const f32x4 a) { return 1.0f / sqrtf(((a[0] + a[1]) + (a[2] + a[3])) * (1.0f / DM) + EPS); }
__device__ __forceinline__ float rstd_of(const GAS float* ssq, int row) { return rstd_from(*(const GAS f32x4*)(ssq + (unsigned)(row * 4))); }

namespace pg8 {
struct EpiGU {
    static constexpr bool PERM = true, AFTER_DRAIN = false;
    GAS bf16_t* act; const GAS float* ssq;
    __device__ __forceinline__ void operator()(const f32x4 (&acc)[2][2][4][2], const Unit& u, int wr, int wc, int fr, int fq) const {
        int row0 = u.pm * BM + wr * 64 + fr; asm volatile("" : "+v"(row0)); const int col = u.pn * 128 + wc * 32 + 8 * fq;
        float rsv[2][4];
#pragma unroll
        for (int ai = 0; ai < 2; ++ai)
#pragma unroll
            for (int m = 0; m < 4; ++m) rsv[ai][m] = rstd_of(ssq, row0 + ai * HALF + m * 16);
#pragma unroll
        for (int ai = 0; ai < 2; ++ai)
#pragma unroll
            for (int m = 0; m < 4; ++m) {
                const int row = row0 + ai * HALF + m * 16; const float rs = rsv[ai][m];
                float a[8];
#pragma unroll
                for (int n = 0; n < 2; ++n)
#pragma unroll
                    for (int i = 0; i < 4; ++i) { const float g = acc[ai][0][m][n][i] * rs, up = acc[ai][1][m][n][i] * rs; a[n * 4 + i] = siluf_(g) * up; }
                u32x4 w; w.x = pk_bf16(a[0], a[1]); w.y = pk_bf16(a[2], a[3]); w.z = pk_bf16(a[4], a[5]); w.w = pk_bf16(a[6], a[7]);
                __builtin_nontemporal_store(w, (GAS u32x4*)(act + (unsigned)(row * FFP + col)));
                asm volatile("" ::: "memory");
            }
    }
};
struct EpiIN {
    static constexpr bool PERM = true, AFTER_DRAIN = false;
    GAS bf16_t* P; GAS float* F; const GAS float* ssq;
    __device__ __forceinline__ void operator()(const f32x4 (&acc)[2][2][4][2], const Unit& u, int wr, int wc, int fr, int fq) const {
        int row0 = u.pm * BM + wr * 64 + fr; asm volatile("" : "+v"(row0)); const int pn = u.pn;
        const bool isf = (pn == 7 || pn == 8 || pn == 13);
        const int pbase = (pn < 7 ? 256 * pn : 256 * (pn - 2)); const float sc = pn < 2 ? 0.125f * LOG2E : 1.0f;
        const int fbase = (pn == 13) ? 512 : 256 * (pn - 7);
        float rsv[2][4];
#pragma unroll
        for (int ai = 0; ai < 2; ++ai)
#pragma unroll
            for (int m = 0; m < 4; ++m) rsv[ai][m] = rstd_of(ssq, row0 + ai * HALF + m * 16) * sc;
#pragma unroll
        for (int ai = 0; ai < 2; ++ai)
#pragma unroll
            for (int m = 0; m < 4; ++m) {
                const int row = row0 + ai * HALF + m * 16; const float rs = rsv[ai][m];
#pragma unroll
                for (int bj = 0; bj < 2; ++bj) {
                    const int c = bj * HALF + wc * 32 + 8 * fq;
                    const f32x4 v0 = acc[ai][bj][m][0] * rs, v1 = acc[ai][bj][m][1] * rs;
                    if (isf) {
                        if (pn != 13 || c < 32) { GAS float* d = F + (unsigned)(row * FW + fbase + c); *(f32x4*)d = v0; *(GAS f32x4*)(d + 4) = v1; }
                    } else {
                        u32x4 w; w.x = pk_bf16(v0[0], v0[1]); w.y = pk_bf16(v0[2], v0[3]); w.z = pk_bf16(v1[0], v1[1]); w.w = pk_bf16(v1[2], v1[3]);
                        *(GAS u32x4*)(P + (unsigned)(row * PW + pbase + c)) = w;
                    }
                }
                asm volatile("" ::: "memory");
            }
    }
};
template <bool XSRC>
struct EpiRES {
    static constexpr bool PERM = false, AFTER_DRAIN = true;
    const GAS float* xsrc; GAS bf16_t* hb; GAS float* ssq; float alpha;
    __device__ __forceinline__ void fused(f32x4 (&acc)[2][2][4][2], const Unit& u, int wr, int wc, int fr, int fq, PG8_LAS unsigned char* lds, int wid, int lane) const {
        int row0 = u.pm * BM + wr * 64 + fr; asm volatile("" : "+v"(row0)); const int col0 = u.pn * BM + wc * 32 + 4 * fq;
        PG8_LAS float* part = (PG8_LAS float*)lds;
#pragma unroll
        for (int ai = 0; ai < 2; ++ai) {
            f32x4 pre[4][2][2];
#pragma unroll
            for (int m = 0; m < 4; ++m)
#pragma unroll
                for (int bj = 0; bj < 2; ++bj)
#pragma unroll
                    for (int n = 0; n < 2; ++n) {
                        const unsigned off = (unsigned)((row0 + ai * HALF + m * 16) * DM + col0 + bj * HALF + n * 16);
                        if (XSRC) pre[m][bj][n] = __builtin_nontemporal_load((const GAS f32x4*)(xsrc + off));
                        else { const u32x2 w = *(const GAS u32x2*)(hb + off); pre[m][bj][n] = (f32x4){bflo(w.x), bfhi(w.x), bflo(w.y), bfhi(w.y)}; }
                    }
#pragma unroll
            for (int m = 0; m < 4; ++m) {
                const int row = row0 + ai * HALF + m * 16; float sq = 0.f;
#pragma unroll
                for (int bj = 0; bj < 2; ++bj)
#pragma unroll
                    for (int n = 0; n < 2; ++n) {
                        const unsigned off = (unsigned)(row * DM + col0 + bj * HALF + n * 16);
                        const f32x4 o = pre[m][bj][n] + acc[ai][bj][m][n] * alpha;
                        u32x2 w; w.x = pk_bf16(o[0], o[1]); w.y = pk_bf16(o[2], o[3]); *(GAS u32x2*)(hb + off) = w;
                        sq += (o[0] * o[0] + o[1] * o[1]) + (o[2] * o[2] + o[3] * o[3]);
                    }
                sq += __shfl_xor(sq, 16); sq += __shfl_xor(sq, 32);
                if (fq == 0) part[(ai * HALF + wr * 64 + m * 16 + fr) * 4 + wc] = sq;
            }
            asm volatile("" ::: "memory");
        }
        asm volatile("s_waitcnt lgkmcnt(0)" ::: "memory"); __builtin_amdgcn_s_barrier(); asm volatile("" ::: "memory");
        const int t = wid * 64 + lane;
        if (t < 256) { const f32x4 p4 = *(const PG8_LAS f32x4*)(part + t * 4); ssq[(unsigned)((u.pm * BM + t) * 4 + u.pn)] = (p4[0] + p4[1]) + (p4[2] + p4[3]); }
        asm volatile("s_waitcnt lgkmcnt(0)" ::: "memory"); __builtin_amdgcn_s_barrier(); asm volatile("" ::: "memory");
    }
};
}

__device__ __forceinline__ int map_col(int mode, int n, int N) {
    if (mode == 0 || mode == 3) return n < N ? n : -1;
    if (mode == 1) { const int t = n >> 8, r = n & 255, c = 128 * t + (r & 127); return c < FF ? (r < 128 ? c : FF + c) : -1; }
    if (n < 1280) return n;
    if (n < 3328) return n + 24;
    if (n < 3352) return 1280 + (n - 3328);
    return -1;
}
__device__ __forceinline__ void conv_item(const GAS float* W, int K, int N, const GAS float* gain, GAS bf16* WT, int KP, int mode, LAS float* scr, int item, int lane) {
    const int kblks = KP >> 6, nb = item / kblks, kb = item - nb * kblks, k0 = 64 * kb, n0 = 64 * nb;
    const int l16 = lane & 15, kq = lane >> 4;
    const int src = map_col(mode, n0 + 4 * l16, N);
    f32x4 v[16];
#pragma unroll
    for (int i = 0; i < 16; ++i) {
        const int k = k0 + 4 * i + kq;
        v[i] = (f32x4){0.f, 0.f, 0.f, 0.f};
        if (src >= 0 && k < K) { v[i] = __builtin_nontemporal_load((const GAS f32x4*)(W + (size_t)k * N + src)); if (gain) v[i] = v[i] * gain[k]; }
    }
#pragma unroll
    for (int i = 0; i < 16; ++i) {
        LAS float* d = scr + (4 * i + kq) * 65 + 4 * l16;
        d[0] = v[i][0]; d[1] = v[i][1]; d[2] = v[i][2]; d[3] = v[i][3];
    }
    asm volatile("s_waitcnt lgkmcnt(0)" ::: "memory");
    const int c = lane & 7;
#pragma unroll
    for (int j = 0; j < 8; ++j) {
        const int n = (lane >> 3) + 8 * j; const LAS float* s = scr + (8 * c) * 65 + n;
        u32x4 o; o.x = pk_bf16(s[0 * 65], s[1 * 65]); o.y = pk_bf16(s[2 * 65], s[3 * 65]); o.z = pk_bf16(s[4 * 65], s[5 * 65]); o.w = pk_bf16(s[6 * 65], s[7 * 65]);
        if (mode == 3) {
            const int nn = n0 + n, k8 = (k0 >> 3) + c;
            *(GAS u32x4*)(WT + ((size_t)((nn >> 4) * (KP >> 5) + (k8 >> 2)) * 64 + (k8 & 3) * 16 + (nn & 15)) * 8) = o;
        } else *(GAS u32x4*)(WT + (size_t)(n0 + n) * KP + k0 + 8 * c) = o;
    }
    asm volatile("s_waitcnt lgkmcnt(0)" ::: "memory");
}

struct Args { const GAS float* in[19]; GAS float* out; GAS unsigned char* ws; int ph_lo, ph_hi; };

__device__ __forceinline__ void prologue(const Args& A, GAS unsigned char* ws, int layer, LAS unsigned char* lds, int tid, int wave, int lane) {
    LAS float* scr = (LAS float*)(lds + wave * 16640);
    const int gw = blockIdx.x * 8 + wave, NGW = gridDim.x * 8;
    constexpr int I_GU = (NGU / 64) * (DM / 64), I_DN = (DM / 64) * (FFP / 64), I_IN = (NIN / 64) * (DM / 64), I_OUT = (DM / 64) * (DM / 64), I_C1 = (256 / 64) * (2048 / 64), I_C2 = (64 / 64) * (256 / 64);
    constexpr int NITEMS = 2 * I_GU + 2 * I_DN + I_IN + I_OUT + 2 * I_C1 + 2 * I_C2;
    const size_t lgu = (size_t)layer * DM * 2 * FF, ldn = (size_t)layer * FF * DM;
    for (int it = gw; it < NITEMS; it += NGW) {
        int r = it;
        if (r < I_GU) { conv_item(A.in[2] + lgu, DM, 2 * FF, A.in[1] + layer * DM, (GAS bf16*)(ws + W_GU1), DM, 1, scr, r, lane); continue; } r -= I_GU;
        if (r < I_GU) { conv_item(A.in[16] + lgu, DM, 2 * FF, A.in[15] + layer * DM, (GAS bf16*)(ws + W_GU2), DM, 1, scr, r, lane); continue; } r -= I_GU;
        if (r < I_DN) { conv_item(A.in[3] + ldn, FF, DM, nullptr, (GAS bf16*)(ws + W_DN1), FFP, 0, scr, r, lane); continue; } r -= I_DN;
        if (r < I_DN) { conv_item(A.in[17] + ldn, FF, DM, nullptr, (GAS bf16*)(ws + W_DN2), FFP, 0, scr, r, lane); continue; } r -= I_DN;
        if (r < I_IN) { conv_item(A.in[5] + (size_t)layer * DM * NINSRC, DM, NINSRC, A.in[4] + layer * DM, (GAS bf16*)(ws + W_IN), DM, 2, scr, r, lane); continue; } r -= I_IN;
        if (r < I_OUT) { conv_item(A.in[14] + (size_t)layer * DM * DM, DM, DM, nullptr, (GAS bf16*)(ws + W_OUT), DM, 0, scr, r, lane); continue; } r -= I_OUT;
        if (r < I_C1) { conv_item(A.in[8] + (size_t)layer * 2048 * 256, 2048, 256, nullptr, (GAS bf16*)(ws + W_C1K), 2048, 3, scr, r, lane); continue; } r -= I_C1;
        if (r < I_C1) { conv_item(A.in[10] + (size_t)layer * 2048 * 256, 2048, 256, nullptr, (GAS bf16*)(ws + W_C1V), 2048, 3, scr, r, lane); continue; } r -= I_C1;
        if (r < I_C2) { conv_item(A.in[9] + (size_t)layer * 256 * 64, 256, 64, nullptr, (GAS bf16*)(ws + W_C2K), 256, 0, scr, r, lane); continue; } r -= I_C2;
        conv_item(A.in[11] + (size_t)layer * 256 * 64, 256, 64, nullptr, (GAS bf16*)(ws + W_C2V), 256, 0, scr, r, lane);
    }
    if (layer == 0) {
        GAS bf16* hb = (GAS bf16*)(ws + WS_HB); GAS float* ssq = (GAS float*)(ws + WS_SSQ); const GAS float* x = A.in[0];
        for (int row = gw; row < T; row += 4 * NGW) {
            f32x4 v[4][4];
#pragma unroll
            for (int r = 0; r < 4; ++r) { const int rw = row + r * NGW; if (rw < T) { const GAS f32x4* xr = (const GAS f32x4*)(x + (size_t)rw * DM) + lane;
#pragma unroll
                for (int j = 0; j < 4; ++j) v[r][j] = __builtin_nontemporal_load(xr + 64 * j); } }
#pragma unroll
            for (int r = 0; r < 4; ++r) { const int rw = row + r * NGW; if (rw < T) { float s = 0.f; GAS u32x2* o = (GAS u32x2*)(hb + (size_t)rw * DM) + lane;
#pragma unroll
                for (int j = 0; j < 4; ++j) { const f32x4 q = v[r][j]; s += (q[0] * q[0] + q[1] * q[1]) + (q[2] * q[2] + q[3] * q[3]); u32x2 w; w.x = pk_bf16(q[0], q[1]); w.y = pk_bf16(q[2], q[3]); o[64 * j] = w; }
                s = wave_sum(s);
                if (lane < 4) ssq[(size_t)rw * 4 + lane] = lane == 0 ? s : 0.f; } }
        }
    }
    __syncthreads();
    const int bx = (int)gridDim.x - 1 - (int)blockIdx.x;
    if (bx < 32) {
        const int kv = bx & 1, part = bx >> 1;
        const GAS float* pos = A.in[kv == 0 ? 6 : 7] + (size_t)layer * 2048; const GAS float* w1 = A.in[kv == 0 ? 8 : 10] + (size_t)layer * 2048 * 256;
        const int n = tid & 255, half = tid >> 8; float s = 0.f;
        const int j0 = part * 128 + half * 64;
#pragma unroll 16
        for (int j = j0; j < j0 + 64; ++j) s += pos[j] * w1[(size_t)j * 256 + n];
        LAS float* red = (LAS float*)(lds + 8 * 16640);
        if (half) red[n] = s;
        __syncthreads();
        if (!half) ((GAS float*)(ws + WS_CB))[(part * 2 + kv) * 256 + n] = s + red[n];
    } else if (bx == 32) {
        const GAS float* lbp = A.in[12]; float v = 0.f;
        if (layer == 1) { const float a0 = lbp[tid], a1 = lbp[512 + tid]; v = 1.0f / (1.0f + expf(a0 - a1)); }
        ((GAS float*)(ws + WS_LB))[tid] = v;
    }
}

#ifndef NTS
#define NTS -1
#endif
#define TACC(k) do { if (NTS >= 0 && blockIdx.x == 0 && tid == 0) { const unsigned long long now_ = __builtin_amdgcn_s_memrealtime(); ((GAS unsigned long long*)(ws + WS_BAR + 16384 + 1024))[k] += now_ - t_prev_; t_prev_ = now_; } } while (0)
#define TSTART unsigned long long t_prev_ = (NTS >= 0) ? __builtin_amdgcn_s_memrealtime() : 0ull
__device__ __forceinline__ void compress_item(GAS unsigned char* ws, int ci, LAS unsigned char* lds, int tid, int wave, int lane) {
    asm volatile("" : "+v"(tid)); lane = tid & 63;
    const int kv = ci >> 6, r0 = (ci & 63) * 32, rr = lane & 15, quad = lane >> 4;
    TSTART;
    const GAS bf16* P = (const GAS bf16*)(ws + WS_P); const GAS bf16* w1t = (const GAS bf16*)(ws + (kv ? W_C1V : W_C1K)); const GAS bf16* w2t = (const GAS bf16*)(ws + (kv ? W_C2V : W_C2K));
    const GAS float* cb = (const GAS float*)(ws + WS_CB) + kv * 256;
    LAS unsigned char* AL = lds;
    LAS bf16* HID = (LAS bf16*)(lds + 32 * 2064);
    const GAS bf16* bp[2];
#pragma unroll
    for (int j = 0; j < 2; ++j) bp[j] = w1t + ((size_t)(2 * wave + j) * 64 * 64 + quad * 16 + rr) * 8;
    f32x4 acc[2][2];
#pragma unroll
    for (int i = 0; i < 2; ++i)
#pragma unroll
        for (int j = 0; j < 2; ++j) acc[i][j] = (f32x4){0.f, 0.f, 0.f, 0.f};
    bf16x8 bcur[8][2], bnxt[8][2];
#pragma unroll
    for (int u = 0; u < 8; ++u)
#pragma unroll
        for (int j = 0; j < 2; ++j) bcur[u][j] = *(const GAS bf16x8*)(bp[j] + u * 512);
#pragma unroll 1
    for (int half = 0; half < 2; ++half) {
        __syncthreads();
#pragma unroll
        for (int c = 0; c < 8; ++c) {
            const int ch = tid + 512 * c, row = ch >> 7, l = (ch >> 3) & 15, piece = ch & 7;
            const int r = r0 + row, b = r >> 9, nb = (r >> 1) & 255, g = r & 1;
            int tok = b * SEQ + nb * 16 + 16 * half + l; tok = tok > T - 1 ? T - 1 : tok;
            const u32x4 v = *(const GAS u32x4*)(P + (size_t)tok * PW + PC_KC + kv * 128 + g * 64 + piece * 8);
            *(LAS u32x4*)(AL + row * 2064 + (l * 64 + piece * 8) * 2) = v;
        }
        __syncthreads();
#pragma unroll 1
        for (int bt = 0; bt < 4; ++bt) {
            const int gnext = (4 * half + bt + 1) * 8;
            if (gnext < 64) {
#pragma unroll
                for (int u = 0; u < 8; ++u)
#pragma unroll
                    for (int j = 0; j < 2; ++j) bnxt[u][j] = *(const GAS bf16x8*)(bp[j] + (gnext + u) * 512);
            }
#pragma unroll
            for (int u = 0; u < 8; ++u) {
                const int ks = 8 * bt + u; bf16x8 a[2];
#pragma unroll
                for (int i = 0; i < 2; ++i) a[i] = *(const LAS bf16x8*)(AL + (16 * i + rr) * 2064 + (32 * ks + 8 * quad) * 2);
#pragma unroll
                for (int i = 0; i < 2; ++i)
#pragma unroll
                    for (int j = 0; j < 2; ++j) acc[i][j] = mfma16(a[i], bcur[u][j], acc[i][j]);
            }
#pragma unroll
            for (int u = 0; u < 8; ++u)
#pragma unroll
                for (int j = 0; j < 2; ++j) bcur[u][j] = bnxt[u][j];
        }
    }
#pragma unroll
    for (int i = 0; i < 2; ++i)
#pragma unroll
        for (int j = 0; j < 2; ++j) {
            const int n = 32 * wave + 16 * j + rr; float bias = 0.f;
#pragma unroll
            for (int pp = 0; pp < 16; ++pp) bias += cb[pp * 512 + n];
#pragma unroll
            for (int e = 0; e < 4; ++e) { const int row = 16 * i + 4 * quad + e; HID[row * 264 + n] = (bf16)(pk_bf16(gelu_tanh(acc[i][j][e] + bias), 0.f) & 0xffffu); }
        }
    __syncthreads();
    {
        const int rti = wave >> 2, cti = wave & 3; f32x4 o = (f32x4){0.f, 0.f, 0.f, 0.f};
#pragma unroll
        for (int ks = 0; ks < 8; ++ks) {
            const bf16x8 a = *(const LAS bf16x8*)(HID + (16 * rti + rr) * 264 + 32 * ks + 8 * quad);
            const bf16x8 b = *(const GAS bf16x8*)(w2t + (size_t)(16 * cti + rr) * 256 + 32 * ks + 8 * quad);
            o = mfma16(a, b, o);
        }
        GAS bf16* dst = (GAS bf16*)(ws + (kv ? WS_VC : WS_KC));
#pragma unroll
        for (int e = 0; e < 4; ++e) {
            const int r = r0 + 16 * rti + 4 * quad + e, b = r >> 9, nb = (r >> 1) & 255, g = r & 1;
            dst[((size_t)(b * 2 + g) * 256 + nb) * 64 + 16 * cti + rr] = nb == 255 ? (bf16)0 : (bf16)(pk_bf16(o[e], 0.f) & 0xffffu);
        }
    }
    TACC(8);
}

__device__ __forceinline__ void hg1_load(GAS unsigned char* ws, int item, int tid, f32x4 (&zr)[4], u32x2 (&hqr)[4], u32x2 (&hir)[4]) {
    const int ch = item & 63, bh = item >> 6, h = bh & 3, b = bh >> 2, tok0 = b * SEQ + ch * 64;
    const GAS bf16* P = (const GAS bf16*)(ws + WS_P); const GAS float* F = (const GAS float*)(ws + WS_F);
#pragma unroll
    for (int i = 0; i < 4; ++i) {
        const int qi = tid + 512 * i, t = qi >> 5, d = (qi & 31) * 4;
        zr[i] = __builtin_nontemporal_load((const GAS f32x4*)(F + (size_t)(tok0 + t) * FW + FC_HF + h * 128 + d));
        const GAS bf16* prow0 = P + (size_t)(tok0 + t) * PW + h * 128 + d;
        hqr[i] = __builtin_nontemporal_load((const GAS u32x2*)(prow0 + PC_HQ)); hir[i] = __builtin_nontemporal_load((const GAS u32x2*)(prow0 + PC_HI));
    }
}
__device__ __forceinline__ void hg_step1(GAS unsigned char* ws, GAS bf16* S, int item, int next_item, f32x4 (&zr)[4], u32x2 (&hqr)[4], u32x2 (&hir)[4], LAS unsigned char* lds, int tid, int wave, int lane) {
    asm volatile("" : "+v"(tid)); lane = tid & 63;
    const int ch = item & 63, bh = item >> 6, h = bh & 3, b = bh >> 2, tok0 = b * SEQ + ch * 64;
    GAS bf16* P = (GAS bf16*)(ws + WS_P); const GAS float* F = (const GAS float*)(ws + WS_F); GAS bf16* MIX = (GAS bf16*)(ws + WS_MIX);
    GAS float* DC = (GAS float*)(ws + WS_DC); const GAS float* LB = (const GAS float*)(ws + WS_LB);
    LAS float* Bc = (LAS float*)lds;
    LAS float* TOT = (LAS float*)(lds + 33792);
    LAS bf16* Qh = (LAS bf16*)(lds + 35840);
    LAS bf16* Kh = (LAS bf16*)(lds + 53248);
    LAS bf16* KgT = (LAS bf16*)(lds + 70656);
    LAS bf16* VT = (LAS bf16*)(lds + 89088);
    LAS bf16* Am = (LAS bf16*)(lds + 107520);
    const int rr = lane & 15, quad = lane >> 4;
    __syncthreads();
    TSTART;
#pragma unroll
    for (int i = 0; i < 4; ++i) {
        const int qi = tid + 512 * i, t = qi >> 5, d = (qi & 31) * 4;
        const f32x4 z = zr[i];
        const f32x4 lb = *(const GAS f32x4*)(LB + h * 128 + d);
        f32x4 lf;
#pragma unroll
        for (int e = 0; e < 4; ++e) { const float f = lb[e] + (1.0f - lb[e]) * sigmoidf_(z[e]); lf[e] = __logf(fmaxf(f, 1e-30f)); }
        *(LAS f32x4*)(Bc + t * 132 + d) = lf;
    }
    __syncthreads();
    {
        const int d = tid & 127, part = tid >> 7; float run = 0.f;
#pragma unroll
        for (int t = 0; t < 16; ++t) { run += Bc[(16 * part + t) * 132 + d]; Bc[(16 * part + t) * 132 + d] = run; }
        TOT[part * 128 + d] = run;
        __syncthreads();
        float off = 0.f;
        for (int p = 0; p < part; ++p) off += TOT[p * 128 + d];
        if (part > 0) {
#pragma unroll
            for (int t = 0; t < 16; ++t) Bc[(16 * part + t) * 132 + d] += off;
        }
    }
    __syncthreads();
    TACC(9);
    const int dq_ = (tid & 31) * 4;
    const f32x4 mm = *(const LAS f32x4*)(Bc + 31 * 132 + dq_), bl = *(const LAS f32x4*)(Bc + 63 * 132 + dq_);
    f32x4 cm, cbl;
#pragma unroll
    for (int e = 0; e < 4; ++e) { cm[e] = fexp(mm[e]); cbl[e] = fexp(bl[e] - mm[e]); }
#pragma unroll
    for (int i = 0; i < 4; ++i) {
        const int qi = tid + 512 * i, t = qi >> 5, d = (qi & 31) * 4;
        const f32x4 z = zr[i];
        const f32x4 lb = *(const GAS f32x4*)(LB + h * 128 + d);
        const u32x2 hq = hqr[i], hi = hir[i];
        const f32x4 bb = *(const LAS f32x4*)(Bc + t * 132 + d);
        const float qv[4] = {bflo(hq.x), bfhi(hq.x), bflo(hq.y), bfhi(hq.y)};
        float qh[4], kh[4], qg[4], kg[4];
#pragma unroll
        for (int e = 0; e < 4; ++e) {
            const float qs = siluf_(qv[e]), kf = (1.0f - lb[e]) * sigmoidf_(-z[e]);
            const float E = fexp(bb[e] - mm[e]), Ei = frcp(E);
            qh[e] = qs * E; kh[e] = kf * Ei; qg[e] = qh[e] * cm[e]; kg[e] = kh[e] * cbl[e];
        }
        u32x2 w; w.x = pk_bf16(qh[0], qh[1]); w.y = pk_bf16(qh[2], qh[3]); *(LAS u32x2*)(Qh + t * 136 + d) = w;
        w.x = pk_bf16(kh[0], kh[1]); w.y = pk_bf16(kh[2], kh[3]); *(LAS u32x2*)(Kh + t * 136 + d) = w;
        w.x = pk_bf16(qg[0], qg[1]); w.y = pk_bf16(qg[2], qg[3]); *(GAS u32x2*)((GAS bf16*)(ws + WS_QG) + (size_t)(tok0 + t) * 512 + h * 128 + d) = w;
        const unsigned k01 = pk_bf16(kg[0], kg[1]), k23 = pk_bf16(kg[2], kg[3]);
        KgT[(d + 0) * 72 + t] = (bf16)(k01 & 0xffffu); KgT[(d + 1) * 72 + t] = (bf16)(k01 >> 16); KgT[(d + 2) * 72 + t] = (bf16)(k23 & 0xffffu); KgT[(d + 3) * 72 + t] = (bf16)(k23 >> 16);
        VT[(d + 0) * 72 + t] = (bf16)(hi.x & 0xffffu); VT[(d + 1) * 72 + t] = (bf16)(hi.x >> 16); VT[(d + 2) * 72 + t] = (bf16)(hi.y & 0xffffu); VT[(d + 3) * 72 + t] = (bf16)(hi.y >> 16);
        if (t == 63) { f32x4 dcv;
#pragma unroll
            for (int e = 0; e < 4; ++e) dcv[e] = fexp(bl[e]);
            *(GAS f32x4*)(DC + (size_t)item * 128 + d) = dcv; }
    }
    __syncthreads();
    TACC(10);
    if (next_item >= 0) hg1_load(ws, next_item, tid, zr, hqr, hir);
    {
        const int ti = wave >> 1;
#pragma unroll
        for (int q = 0; q < 2; ++q) {
            const int si = (wave & 1) * 2 + q; f32x4 acc = (f32x4){0.f, 0.f, 0.f, 0.f};
            if (si <= ti) {
#pragma unroll
                for (int ks = 0; ks < 4; ++ks) {
                    const bf16x8 a = *(const LAS bf16x8*)(Qh + (16 * ti + rr) * 136 + 32 * ks + 8 * quad);
                    const bf16x8 bq = *(const LAS bf16x8*)(Kh + (16 * si + rr) * 136 + 32 * ks + 8 * quad);
                    acc = mfma16(a, bq, acc);
                }
            }
#pragma unroll
            for (int e = 0; e < 4; ++e) { const int t = 16 * ti + 4 * quad + e, s = 16 * si + rr; const float v = (s <= t) ? acc[e] : 0.f; Am[t * 72 + s] = (bf16)(pk_bf16(v, 0.f) & 0xffffu); }
        }
    }
    asm volatile("s_waitcnt lgkmcnt(0)" ::: "memory"); __builtin_amdgcn_s_barrier(); asm volatile("" ::: "memory");
    {
        const int ti = wave & 3;
#pragma unroll
        for (int q = 0; q < 4; ++q) {
            const int vi = (wave >> 2) * 4 + q; f32x4 acc = (f32x4){0.f, 0.f, 0.f, 0.f};
#pragma unroll
            for (int ks = 0; ks < 2; ++ks) {
                const bf16x8 a = *(const LAS bf16x8*)(VT + (16 * vi + rr) * 72 + 32 * ks + 8 * quad);
                const bf16x8 bq = *(const LAS bf16x8*)(Am + (16 * ti + rr) * 72 + 32 * ks + 8 * quad);
                acc = mfma16(a, bq, acc);
            }
            u32x2 w; w.x = pk_bf16(acc[0], acc[1]); w.y = pk_bf16(acc[2], acc[3]);
            *(GAS u32x2*)(MIX + (size_t)(tok0 + 16 * ti + rr) * DM + 512 + h * 128 + 16 * vi + 4 * quad) = w;
        }
#pragma unroll
        for (int vi = 0; vi < 8; ++vi) {
            f32x4 acc = (f32x4){0.f, 0.f, 0.f, 0.f};
#pragma unroll
            for (int ks = 0; ks < 2; ++ks) {
                const bf16x8 a = *(const LAS bf16x8*)(KgT + (16 * wave + rr) * 72 + 32 * ks + 8 * quad);
                const bf16x8 bq = *(const LAS bf16x8*)(VT + (16 * vi + rr) * 72 + 32 * ks + 8 * quad);
                acc = mfma16(a, bq, acc);
            }
            u32x2 w; w.x = pk_bf16(acc[0], acc[1]); w.y = pk_bf16(acc[2], acc[3]);
            *(GAS u32x2*)(S + (size_t)item * 16384 + (16 * vi + rr) * 128 + 16 * wave + 4 * quad) = w;
        }
    }    TACC(11);
}
__device__ __forceinline__ void hg_scan(GAS unsigned char* ws, GAS bf16* S, int tid, bool dummy = false) {
    const GAS float* DC = (const GAS float*)(ws + WS_DC);
    for (int gt = blockIdx.x * 512 + tid; gt < 131072; gt += gridDim.x * 512) {
        const int bh = gt >> 13, e = (gt & 8191) * 2, d = e & 127;
        float s0 = 0.f, s1 = 0.f;
        GAS unsigned* p = (GAS unsigned*)(S + (size_t)bh * 64 * 16384 + e); const GAS float* dc = DC + (size_t)bh * 64 * 128 + d;
        unsigned sv[16]; f32x2 dv[16];
#pragma unroll
        for (int j = 0; j < 16; ++j) { sv[j] = p[(size_t)j * 8192]; dv[j] = *(const GAS f32x2*)(dc + j * 128); }
#pragma unroll 1
        for (int cb = 0; cb < 4; ++cb) {
            unsigned nsv[16]; f32x2 ndv[16];
            if (cb < 3) {
#pragma unroll
                for (int j = 0; j < 16; ++j) { nsv[j] = p[(size_t)(16 * cb + 16 + j) * 8192]; ndv[j] = *(const GAS f32x2*)(dc + (16 * cb + 16 + j) * 128); }
            }
#pragma unroll
            for (int j = 0; j < 16; ++j) {
                if (!dummy || s0 == 12345.678f) p[(size_t)(16 * cb + j) * 8192] = pk_bf16(s0, s1);
                s0 = dv[j][0] * s0 + bflo(sv[j]); s1 = dv[j][1] * s1 + bfhi(sv[j]);
            }
            if (cb < 3) {
#pragma unroll
                for (int j = 0; j < 16; ++j) { sv[j] = nsv[j]; dv[j] = ndv[j]; }
            }
        }
    }
}
__device__ __forceinline__ void hg_step3(GAS unsigned char* ws, const GAS bf16* Sb, const GAS float* onorm, int item, LAS unsigned char* lds, int tid, int wave, int lane, bool scratch_out = false) {
    asm volatile("" : "+v"(tid)); lane = tid & 63;
    const int ch = item & 63, bh = item >> 6, h = bh & 3, b = bh >> 2, tok0 = b * SEQ + ch * 64;
    const GAS bf16* P = (const GAS bf16*)(ws + WS_P); GAS bf16* MIX = (GAS bf16*)(ws + WS_MIX); const GAS bf16* S = Sb + (size_t)item * 16384;
    LAS float* red = (LAS float*)lds;
    LAS unsigned char* SL = lds + 1024;
    LAS unsigned char* QL = lds + 1024 + 128 * 272;
    const int rr = lane & 15, quad = lane >> 4, ti = wave & 3, vh = wave >> 2, t = 16 * ti + rr, tok = tok0 + t;
    TSTART;
    __syncthreads();
    {
        const GAS bf16* QG = (const GAS bf16*)(ws + WS_QG) + (size_t)tok0 * 512 + h * 128;
#pragma unroll
        for (int i = 0; i < 4; ++i) { const int c = tid + 512 * i, row = c >> 4, piece = c & 15; *(LAS u32x4*)(SL + row * 272 + piece * 16) = __builtin_nontemporal_load((const GAS u32x4*)(S + row * 128 + piece * 8)); }
#pragma unroll
        for (int i = 0; i < 2; ++i) { const int c = tid + 512 * i, row = c >> 4, piece = c & 15; *(LAS u32x4*)(QL + row * 272 + piece * 16) = __builtin_nontemporal_load((const GAS u32x4*)(QG + (size_t)row * 512 + piece * 8)); }
    }
    __syncthreads();
    bf16x8 bq[4];
#pragma unroll
    for (int ks = 0; ks < 4; ++ks) bq[ks] = *(const LAS bf16x8*)(QL + t * 272 + (32 * ks + 8 * quad) * 2);
    f32x4 o[4]; float sq = 0.f;
#pragma unroll
    for (int q = 0; q < 4; ++q) {
        const int vi = 4 * vh + q; f32x4 acc = (f32x4){0.f, 0.f, 0.f, 0.f};
#pragma unroll
        for (int ks = 0; ks < 4; ++ks) { const bf16x8 a = *(const LAS bf16x8*)(SL + (16 * vi + rr) * 272 + (32 * ks + 8 * quad) * 2); acc = mfma16(a, bq[ks], acc); }
        const u32x2 oi = *(const GAS u32x2*)(MIX + (size_t)tok * DM + 512 + h * 128 + 16 * vi + 4 * quad);
        acc[0] += bflo(oi.x); acc[1] += bfhi(oi.x); acc[2] += bflo(oi.y); acc[3] += bfhi(oi.y);
        o[q] = acc; sq += (acc[0] * acc[0] + acc[1] * acc[1]) + (acc[2] * acc[2] + acc[3] * acc[3]);
    }
    sq += __shfl_xor(sq, 16); sq += __shfl_xor(sq, 32);
    __syncthreads();
    if (quad == 0) red[vh * 64 + t] = sq;
    __syncthreads();
    const float rs = 1.0f / sqrtf((red[t] + red[64 + t]) * (1.0f / 128.0f) + EPS);
#pragma unroll
    for (int q = 0; q < 4; ++q) {
        const int v = 16 * (4 * vh + q) + 4 * quad;
        const f32x4 on = *(const GAS f32x4*)(onorm + v);
        const u32x2 g = *(const GAS u32x2*)(P + (size_t)tok * PW + PC_HG + h * 128 + v);
        const float r0 = o[q][0] * rs * on[0] * siluf_(bflo(g.x)), r1 = o[q][1] * rs * on[1] * siluf_(bfhi(g.x)), r2 = o[q][2] * rs * on[2] * siluf_(bflo(g.y)), r3 = o[q][3] * rs * on[3] * siluf_(bfhi(g.y));
        u32x2 w; w.x = pk_bf16(r0, r1); w.y = pk_bf16(r2, r3);
        if (scratch_out) *(GAS u32x2*)((GAS bf16*)(ws + WS_F) + (size_t)tok * (FW * 2) + h * 128 + v) = w;
        else *(GAS u32x2*)(MIX + (size_t)tok * DM + 512 + h * 128 + v) = w;
    }    TACC(12);
}

template <int MODE>
__device__ __forceinline__ void nsa_scores(f32x16& p0, f32x16& p1, const LAS unsigned char* Kt, const LAS unsigned char* qptr, int lane, float base, float sl2) {
    constexpr float STR = (MODE == 0) ? 16.f : 1.f;
    bf16x8 qf[4];
#pragma unroll
    for (int ks = 0; ks < 4; ++ks) qf[ks] = *(const LAS bf16x8*)(qptr + 1024 * ks);
    const LAS unsigned char* kb = Kt + (lane & 31) * 144 + (lane >> 5) * 16;
    const float b1 = base + sl2 * (32.f * STR);
#pragma unroll
    for (int r = 0; r < 16; ++r) { const float c = (float)((r & 3) + 8 * (r >> 2)) * STR; p0[r] = sl2 * c + base; p1[r] = sl2 * c + b1; }
    bf16x8 ka0[4], ka1[4];
#pragma unroll
    for (int ks = 0; ks < 4; ++ks) { ka0[ks] = *(const LAS bf16x8*)(kb + ks * 32); ka1[ks] = *(const LAS bf16x8*)(kb + 32 * 144 + ks * 32); }
    __builtin_amdgcn_sched_barrier(0);
#pragma unroll
    for (int ks = 0; ks < 4; ++ks) { p0 = mfma32(ka0[ks], qf[ks], p0); p1 = mfma32(ka1[ks], qf[ks], p1); }
}
template <int MODE>
__device__ __forceinline__ void nsa_mask(f32x16& p0, f32x16& p1, float d0) {
    constexpr float STR = (MODE == 0) ? 16.f : 1.f;
#pragma unroll
    for (int r = 0; r < 16; ++r) {
        const float c0 = (float)((r & 3) + 8 * (r >> 2)) * STR, c1 = c0 + 32.f * STR;
        bool v0 = d0 >= c0, v1 = d0 >= c1;
        if (MODE == 2) { v0 = v0 && (d0 - c0) < 512.f; v1 = v1 && (d0 - c1) < 512.f; }
        p0[r] = v0 ? p0[r] : -INFINITY; p1[r] = v1 ? p1[r] : -INFINITY;
    }
}
__device__ __forceinline__ float max3f_(float a, float b, float c) { float r; asm("v_max3_f32 %0, %1, %2, %3" : "=v"(r) : "v"(a), "v"(b), "v"(c)); return r; }
typedef short v4i16_t __attribute__((ext_vector_type(4)));
__device__ __forceinline__ s16x4 vtr(const LAS unsigned char* p) { return __builtin_bit_cast(s16x4, __builtin_amdgcn_ds_read_tr16_b64_v4i16((LAS v4i16_t*)p)); }
__device__ __forceinline__ void nsa_softmax_pv(f32x16& p0, f32x16& p1, const LAS unsigned char* Vt, float& m, float& l, f32x16 (&oT)[2], int lane) {
    float mx = max3f_(p0[0], p1[0], p0[1]), mx2 = max3f_(p1[1], p0[2], p1[2]);
#pragma unroll
    for (int r = 3; r < 15; r += 2) { mx = max3f_(mx, p0[r], p1[r]); mx2 = max3f_(mx2, p0[r + 1], p1[r + 1]); }
    mx = max3f_(mx, p0[15], p1[15]);
    mx = max3f_(mx, mx2, __shfl_xor(mx, 32));
    mx = max3f_(mx, mx, __shfl_xor(mx2, 32));
    const float mn = max3f_(m, mx, mx);
    if (__any(mn != m)) {
        const float alpha = fexp2(m - mn); l *= alpha;
#pragma unroll
        for (int r = 0; r < 16; ++r) { oT[0][r] *= alpha; oT[1][r] *= alpha; }
        m = mn;
    }
    float ps = 0.f;
#pragma unroll
    for (int r = 0; r < 16; ++r) { p0[r] = fexp2(p0[r] - mn); p1[r] = fexp2(p1[r] - mn); ps += p0[r] + p1[r]; }
    l += ps;
    const LAS unsigned char* vb = Vt + (4 * (lane >> 5) + ((lane & 15) >> 2)) * 144 + (16 * ((lane >> 4) & 1) + 4 * (lane & 3)) * 2;
#pragma unroll
    for (int half = 0; half < 2; ++half) {
        s16x4 vl[2][2][2];
#pragma unroll
        for (int sl = 0; sl < 2; ++sl)
#pragma unroll
            for (int dt = 0; dt < 2; ++dt) { const int sidx = 2 * half + sl; vl[sl][dt][0] = vtr(vb + (16 * sidx) * 144 + dt * 64); vl[sl][dt][1] = vtr(vb + (16 * sidx + 8) * 144 + dt * 64); }
        __builtin_amdgcn_sched_barrier(0);
#pragma unroll
        for (int sl = 0; sl < 2; ++sl) {
            const f32x16& pp = half ? p1 : p0; const int o = 8 * sl;
            const unsigned w0 = pk_bf16(pp[o + 0], pp[o + 1]), w1 = pk_bf16(pp[o + 2], pp[o + 3]), w2 = pk_bf16(pp[o + 4], pp[o + 5]), w3 = pk_bf16(pp[o + 6], pp[o + 7]);
            const u32x4 wv = {w0, w1, w2, w3}; const bf16x8 bp = __builtin_bit_cast(bf16x8, wv);
#pragma unroll
            for (int dt = 0; dt < 2; ++dt) {
                const bf16x8 av = {vl[sl][dt][0][0], vl[sl][dt][0][1], vl[sl][dt][0][2], vl[sl][dt][0][3], vl[sl][dt][1][0], vl[sl][dt][1][1], vl[sl][dt][1][2], vl[sl][dt][1][3]};
                oT[dt] = mfma32(av, bp, oT[dt]);
            }
        }
    }
}

__device__ __forceinline__ void nsa_load_kv(const GAS bf16* P, int tokb, int kcol, int vcol, int tid, u32x4& kr, u32x4& vr) {
    const int row = tid >> 3, ch = tid & 7; const GAS bf16* p = P + (size_t)(tokb + row) * PW + ch * 8;
    kr = *(const GAS u32x4*)(p + kcol); vr = *(const GAS u32x4*)(p + vcol);
}
__device__ __forceinline__ void nsa_store_kv(LAS unsigned char* Kt, LAS unsigned char* Vt, int tid, const u32x4& kr, const u32x4& vr) {
    const int row = tid >> 3, ch = tid & 7;
    *(LAS u32x4*)(Kt + row * 144 + ch * 16) = kr;
    *(LAS u32x4*)(Vt + row * 144 + ch * 16) = vr;
}

template <int MODE>
__device__ __forceinline__ void nsa_step(const LAS unsigned char* qf, int jc, int qt, int qpos, float sl2, unsigned long long mymask, LAS unsigned char* Kt, LAS unsigned char* Vt, int lane, float& m, float& l, f32x16 (&oT)[2]) {
    f32x16 p0, p1;
    const float d0 = (float)(qpos - 64 * jc - 4 * (lane >> 5));
    const bool ok = (MODE == 2) || ((mymask >> jc) & 1ull);
    if (MODE == 2 || __any(ok)) {
        nsa_scores<MODE>(p0, p1, Kt, qf, lane, ok ? -sl2 * d0 : -INFINITY, sl2);
        if (jc == qt || (MODE == 2 && jc == qt - 8)) nsa_mask<MODE>(p0, p1, d0);
        nsa_softmax_pv(p0, p1, Vt, m, l, oT, lane);
    }
}
template <int MODE>
__device__ __forceinline__ void nsa_branch(const GAS bf16* P, unsigned long long blocks, int b, int g, int qt, int qpos, float sl2, unsigned long long mymask, const LAS unsigned char* qf,
                                           LAS unsigned char* lds, int tid, int lane, float& m, float& l, f32x16 (&oT)[2]) {
    const int kcol = (MODE == 1 ? PC_KS : PC_KW) + g * 64, vcol = (MODE == 1 ? PC_VS : PC_VW) + g * 64;
    u32x4 kr, vr; int it = 0;
    int j = blocks ? 63 - __builtin_clzll(blocks) : 0;
    if (blocks) nsa_load_kv(P, b * SEQ + 64 * j, kcol, vcol, tid, kr, vr);
    while (blocks) {
        blocks &= ~(1ull << j);
        LAS unsigned char* Kt = lds + (it & 1) * 18432; LAS unsigned char* Vt = Kt + 9216;
        nsa_store_kv(Kt, Vt, tid, kr, vr);
        const int jc = j;
        if (blocks) { j = 63 - __builtin_clzll(blocks); nsa_load_kv(P, b * SEQ + 64 * j, kcol, vcol, tid, kr, vr); }
        __syncthreads();
        nsa_step<MODE>(qf, jc, qt, qpos, sl2, mymask, Kt, Vt, lane, m, l, oT);
        ++it;
    }
}

#define NSA_T(k) do { if (NTS >= 0 && blockIdx.x == 0 && tid == 0) { const unsigned long long now_ = __builtin_amdgcn_s_memrealtime(); ((GAS unsigned long long*)(ws + WS_BAR + 16384 + 1024))[k] += now_ - t_prev_; t_prev_ = now_; } } while (0)
__device__ __forceinline__ void nsa_tile(GAS unsigned char* ws, int b, int g, int qt, LAS unsigned char* lds, int tid, int wave, int lane) {
    asm volatile("" : "+v"(tid)); lane = tid & 63;
    const GAS bf16* P = (const GAS bf16*)(ws + WS_P); const GAS float* F = (const GAS float*)(ws + WS_F); GAS bf16* MIX = (GAS bf16*)(ws + WS_MIX);
    const int hh = wave & 3, head = g * 4 + hh, s0 = qt * 64, qpos = s0 + (wave >> 2) * 32 + (lane & 31), tok = b * SEQ + qpos, hi = lane >> 5;
    const float sl2 = exp2f(-(float)(head + 1)) * LOG2E;
    LAS unsigned char* KC = lds; LAS unsigned char* VCT = lds + 36864;
    unsigned long long t_prev_ = (NTS >= 0) ? __builtin_amdgcn_s_memrealtime() : 0ull;
    LAS unsigned* PSLC = (LAS unsigned*)(lds + 73728); LAS unsigned long long* SELM = (LAS unsigned long long*)(lds + 90624); LAS unsigned long long* UM = (LAS unsigned long long*)(lds + 91136);
    __syncthreads();
    {
        const GAS bf16* kc = (const GAS bf16*)(ws + WS_KC) + (size_t)(b * 2 + g) * 256 * 64; const GAS bf16* vc = (const GAS bf16*)(ws + WS_VC) + (size_t)(b * 2 + g) * 256 * 64;
#pragma unroll
        for (int i = 0; i < 4; ++i) {
            const int ci = tid + 512 * i, row = ci >> 3, ch = ci & 7;
            const u32x4 kr = *(const GAS u32x4*)(kc + row * 64 + ch * 8), vr = *(const GAS u32x4*)(vc + row * 64 + ch * 8);
            *(LAS u32x4*)(KC + row * 144 + ch * 16) = kr;
            *(LAS u32x4*)(VCT + row * 144 + ch * 16) = vr;
        }
#pragma unroll
        for (int i = 0; i < 9; ++i) if (tid + 512 * i < 64 * 65) PSLC[tid + 512 * i] = 0u;
    }
    LAS unsigned char* qf = lds + 98304 + wave * 4096 + lane * 16;
    {
        const GAS bf16* qg = P + (size_t)tok * PW + PC_Q + head * 64 + 8 * hi;
#pragma unroll
        for (int ks = 0; ks < 4; ++ks) *(LAS bf16x8*)(qf + 1024 * ks) = *(const GAS bf16x8*)(qg + 16 * ks);
    }
    const float g0 = sigmoidf_(F[(size_t)tok * FW + FC_GATE + head * 3 + 0]);
    f32x16 outa[2];
    __syncthreads();
    NSA_T(4);
    const int cmin = (s0 - 31) >> 4;
    const int cmax = (s0 + 32) >> 4, nblk = (cmax >> 6) + 1 > 4 ? 4 : (cmax >> 6) + 1;
    {
        float m = NEGB, l = 0.f; f32x16 oT[2];
#pragma unroll
        for (int r = 0; r < 16; ++r) { oT[0][r] = 0.f; oT[1][r] = 0.f; }
        for (int blk = nblk - 1; blk >= 0; --blk) {
            f32x16 p0, p1;
            const float d0 = (float)(qpos - 31 - 16 * (64 * blk + 4 * hi));
            nsa_scores<0>(p0, p1, KC + blk * 64 * 144, qf, lane, -sl2 * d0, sl2);
            if (64 * blk + 63 > cmin) nsa_mask<0>(p0, p1, d0);
            nsa_softmax_pv(p0, p1, VCT + blk * 64 * 144, m, l, oT, lane);
        }
        l += __shfl_xor(l, 32);
        const float il = l > 0.f ? 1.0f / l : 0.f, sc = g0 * il;
#pragma unroll
        for (int r = 0; r < 16; ++r) { outa[0][r] = oT[0][r] * sc; outa[1][r] = oT[1][r] * sc; }
        NSA_T(5);
        LAS unsigned* prow = PSLC + ((wave >> 2) * 32 + (lane & 31)) * 65;
        for (int blk = 0; blk < nblk; ++blk) {
            f32x16 p0, p1;
            const float d0 = (float)(qpos - 31 - 16 * (64 * blk + 4 * hi));
            nsa_scores<0>(p0, p1, KC + blk * 64 * 144, qf, lane, -sl2 * d0, sl2);
            if (64 * blk + 63 > cmin) nsa_mask<0>(p0, p1, d0);
#pragma unroll
            for (int t2 = 0; t2 < 2; ++t2)
#pragma unroll
                for (int gq = 0; gq < 4; ++gq) {
                    const f32x16& pp = t2 ? p1 : p0; float e[4];
#pragma unroll
                    for (int i = 0; i < 4; ++i) e[i] = fexp2(pp[4 * gq + i] - m) * il;
                    const float a = 2.0f * ((e[0] + e[1]) + e[2]) + e[3], c = e[3];
                    const int jb = 16 * blk + 8 * t2 + 2 * gq + hi;
                    if (a > 0.f) atomicAdd((unsigned*)(prow + jb), (unsigned)(a * 268435456.0f + 0.5f));
                    if (c > 0.f && jb < 63) atomicAdd((unsigned*)(prow + jb + 1), (unsigned)(c * 268435456.0f + 0.5f));
                }
        }
    }
    __syncthreads();
    NSA_T(0);
    {
        unsigned long long um = 0ull;
        for (int qq = 0; qq < 8; ++qq) {
            const int q = wave * 8 + qq; const unsigned v = PSLC[q * 65 + lane];
            unsigned key;
            if (lane == 0 || lane == qt || lane == qt - 1) key = 0xffffffffu;
            else if (lane <= qt) key = v >= 0xfffffffdu ? 0xfffffffeu : v + 1u;
            else key = 0u;
            unsigned thr = 0u;
#pragma unroll
            for (int bit = 31; bit >= 0; --bit) { const unsigned c = thr | (1u << bit); if (__popcll(__ballot(key >= c)) >= 16) thr = c; }
            const unsigned long long gt = __ballot(key > thr), eq = __ballot(key == thr);
            const int need = 16 - __popcll(gt);
            const int below = __builtin_amdgcn_mbcnt_hi((unsigned)(eq >> 32), __builtin_amdgcn_mbcnt_lo((unsigned)eq, 0u));
            unsigned long long sel = gt | __ballot(key == thr && below < need);
            sel &= (qt >= 63) ? ~0ull : ((2ull << qt) - 1ull);
            if (lane == 0) SELM[q] = sel;
            um |= sel;
        }
        if (lane == 0) UM[wave] = um;
    }
    __syncthreads();
    NSA_T(1);
    unsigned long long ublocks = 0ull;
#pragma unroll
    for (int i = 0; i < 8; ++i) ublocks |= UM[i];
    const unsigned long long mymask = SELM[(wave >> 2) * 32 + (lane & 31)];
    if (NTS >= 0 && blockIdx.x == 0 && tid == 0) {
        GAS unsigned long long* a_ = (GAS unsigned long long*)(ws + WS_BAR + 16384 + 1024);
        a_[6] += 100ull * (unsigned long long)__popcll(ublocks);
        unsigned long long w0 = 0ull; for (int i_ = 0; i_ < 32; ++i_) w0 |= SELM[i_];
        a_[7] += 100ull * (unsigned long long)__popcll(w0);
        unsigned long long w16 = 0ull; for (int i_ = 0; i_ < 16; ++i_) w16 |= SELM[i_];
        a_[13] += 100ull * (unsigned long long)__popcll(w16);
    }
    {
        float m = NEGB, l = 0.f; f32x16 oT[2];
#pragma unroll
        for (int r = 0; r < 16; ++r) { oT[0][r] = 0.f; oT[1][r] = 0.f; }
        nsa_branch<1>(P, ublocks, b, g, qt, qpos, sl2, mymask, qf, lds, tid, lane, m, l, oT);
        l += __shfl_xor(l, 32);
        const float g1 = sigmoidf_(F[(size_t)tok * FW + FC_GATE + head * 3 + 1]);
        const float sc = l > 0.f ? g1 / l : 0.f;
#pragma unroll
        for (int r = 0; r < 16; ++r) { outa[0][r] += oT[0][r] * sc; outa[1][r] += oT[1][r] * sc; }
    }
    __syncthreads();
    NSA_T(2);
    {
        float m = NEGB, l = 0.f; f32x16 oT[2];
#pragma unroll
        for (int r = 0; r < 16; ++r) { oT[0][r] = 0.f; oT[1][r] = 0.f; }
        const int jlo = qt >= 8 ? qt - 8 : 0;
        const unsigned long long upto = (qt >= 63) ? ~0ull : ((2ull << qt) - 1ull);
        const unsigned long long wblocks = upto & ~((1ull << jlo) - 1ull);
        nsa_branch<2>(P, wblocks, b, g, qt, qpos, sl2, 0ull, qf, lds, tid, lane, m, l, oT);
        l += __shfl_xor(l, 32);
        const float g2 = sigmoidf_(F[(size_t)tok * FW + FC_GATE + head * 3 + 2]);
        const float sc = l > 0.f ? g2 / l : 0.f;
#pragma unroll
        for (int r = 0; r < 16; ++r) { outa[0][r] += oT[0][r] * sc; outa[1][r] += oT[1][r] * sc; }
    }
#pragma unroll
    for (int dt = 0; dt < 2; ++dt)
#pragma unroll
        for (int gq = 0; gq < 4; ++gq) {
            u32x2 w; w.x = pk_bf16(outa[dt][4 * gq], outa[dt][4 * gq + 1]); w.y = pk_bf16(outa[dt][4 * gq + 2], outa[dt][4 * gq + 3]);
            *(GAS u32x2*)(MIX + (size_t)tok * DM + head * 64 + 32 * dt + 8 * gq + 4 * hi) = w;
        }    NSA_T(3);
}
#define XB_TMO      128
#define XB_XCNT(j)  (256  + 64 * (j))
#define XB_XSUB(j)  (1280 + 64 * (j))
#define XB_XGEN(j)  (2304 + 64 * (j))
#define XB_TOP      3328
#define XB_TOPGEN   3392
#define XCD_BAR_WORDS 3456
#define XB_SPIN_CAP (1u << 18)

__device__ __forceinline__ unsigned xb_ld(unsigned* p)              { return __hip_atomic_load(p, __ATOMIC_RELAXED, __HIP_MEMORY_SCOPE_AGENT); }
__device__ __forceinline__ unsigned xb_add(unsigned* p, unsigned v) { return __hip_atomic_fetch_add(p, v, __ATOMIC_RELAXED, __HIP_MEMORY_SCOPE_AGENT); }
__device__ __forceinline__ unsigned xb_xcc_id() { return (unsigned)__builtin_amdgcn_s_getreg((3 << 11) | 20) & 0xFu; }
#define XB_SPIN(cond, bar) do { unsigned _sp = 0; while (cond) { __builtin_amdgcn_s_sleep(1); \
    if ((++_sp & 255u) == 0u) { if (xb_ld(&(bar)[XB_TMO])) break; if (_sp > XB_SPIN_CAP) { atomicAdd(&(bar)[XB_TMO], 1u); break; } } } } while (0)

struct XcdBarrier {
    unsigned* bar; unsigned x;
    volatile LAS unsigned* st;
};

__device__ __forceinline__ XcdBarrier xcd_barrier_post(unsigned* bar, volatile LAS unsigned* st) {
    XcdBarrier b; b.bar = bar; b.x = xb_xcc_id(); b.st = st;
    if (threadIdx.x == 0) (void)xb_add(&bar[XB_XCNT(b.x)], 1u);
    return b;
}
__device__ __forceinline__ void xcd_barrier_complete(unsigned* bar, unsigned x, unsigned& nloc, unsigned& nx) {
    const unsigned G = gridDim.x * gridDim.y * gridDim.z;
    unsigned sum, cnt, mine, sp = 0u;
    for (;;) {
        sum = 0u; cnt = 0u; mine = 0u;
#pragma unroll
        for (unsigned j = 0; j < 16; ++j) { const unsigned c = xb_ld(&bar[XB_XCNT(j)]); sum += c; cnt += (c > 0u) ? 1u : 0u; mine = (j == x) ? c : mine; }
        if (sum == G) break;
        __builtin_amdgcn_s_sleep(1);
        if ((++sp & 255u) == 0u) { if (xb_ld(&bar[XB_TMO])) break; if (sp > XB_SPIN_CAP) { atomicAdd(&bar[XB_TMO], 1u); break; } }
    }
    nloc = mine > 0u ? mine : 1u; nx = cnt > 0u ? cnt : 1u;
}

__device__ __forceinline__ void xcd_barrier(const XcdBarrier& b) {
    asm volatile("s_waitcnt vmcnt(0)" ::: "memory");
    __syncthreads();
    if (threadIdx.x == 0) {
        unsigned* bar = b.bar;
        __builtin_amdgcn_s_waitcnt(0);
        unsigned nloc = b.st[0], nx = b.st[1];
        if (nloc == 0u) { xcd_barrier_complete(bar, b.x, nloc, nx); b.st[0] = nloc; b.st[1] = nx; }
        const unsigned old = xb_add(&bar[XB_XSUB(b.x)], 1u);
        const unsigned gen = old / nloc;
        if (old + 1u == (gen + 1u) * nloc) {
            __builtin_amdgcn_fence(__ATOMIC_RELEASE, "agent");
            asm volatile("s_waitcnt vmcnt(0)" ::: "memory");
            const unsigned og = xb_add(&bar[XB_TOP], 1u);
            const unsigned tg = og / nx;
            if (og + 1u == (tg + 1u) * nx) xb_add(&bar[XB_TOPGEN], 1u);
            else XB_SPIN(xb_ld(&bar[XB_TOPGEN]) == tg, bar);
            __builtin_amdgcn_fence(__ATOMIC_ACQUIRE, "agent");
            xb_add(&bar[XB_XGEN(b.x)], 1u);
            asm volatile("s_waitcnt vmcnt(0)" ::: "memory");
        } else {
            XB_SPIN(xb_ld(&bar[XB_XGEN(b.x)]) == gen, bar);
            __builtin_amdgcn_fence(__ATOMIC_ACQUIRE, "agent");
            asm volatile("s_waitcnt vmcnt(0)" ::: "memory");
        }
    }
    __syncthreads();
}

#ifndef PROBE_REP
#define PROBE_REP 0
#endif
#ifndef TSP
#define TSP -1
#endif
template <class Tp> __device__ __forceinline__ Tp* launder(Tp* p) { unsigned long long v = (unsigned long long)p; asm volatile("" : "+s"(v)); return (Tp*)v; }
template <class Tp> __device__ __forceinline__ GAS Tp* launder(GAS Tp* p) { unsigned long long v = (unsigned long long)p; asm volatile("" : "+s"(v)); return (GAS Tp*)v; }
__global__ void __launch_bounds__(512, 2) hymba_fwd(Args A) {
    extern __shared__ __attribute__((aligned(16))) unsigned char smem[];
    LAS unsigned char* lds = (LAS unsigned char*)smem;
    cg::grid_group grid = cg::this_grid();
    const int tid0 = threadIdx.x, wave = __builtin_amdgcn_readfirstlane(tid0 >> 6);
    GAS unsigned char* ws0 = A.ws;
#define HB ((GAS bf16*)(ws + WS_HB))
#define MIX ((GAS bf16*)(ws + WS_MIX))
#define Pb ((GAS bf16*)(ws + WS_P))
#define Fb ((GAS float*)(ws + WS_F))
#define SSQ ((GAS float*)(ws + WS_SSQ))
    GAS bf16* SB = (GAS bf16*)A.out;
    const int lo = A.ph_lo, hi = A.ph_hi; int ph = 0;
    if (TSP >= 0 && blockIdx.x == 0 && tid0 == 0) ((GAS unsigned long long*)(ws0 + WS_BAR + 16384))[0] = __builtin_amdgcn_s_memrealtime();
    volatile LAS unsigned* xst = (volatile LAS unsigned*)(lds + LDS_BYTES - 64);
    if (tid0 < 2) xst[tid0] = 0u;
    __syncthreads();
    const XcdBarrier xbar = xcd_barrier_post((unsigned*)(ws0 + WS_BAR), xst);
#define PH_BEGIN if (ph >= lo && ph < hi) { int tid = tid0; asm volatile("" : "+v"(tid)); const int lane = tid & 63; GAS unsigned char* ws = launder(ws0);
#define PH_END } if (TSP >= 0 && blockIdx.x == 0 && tid0 == 0) ((GAS unsigned long long*)(ws0 + WS_BAR + 16384))[ph + 1] = __builtin_amdgcn_s_memrealtime(); if (ph >= lo && ph + 1 < hi) { if (hi < 0) grid.sync();   xcd_barrier(xbar); } ++ph;

    for (int layer = 0; layer < 2; ++layer) {
        PH_BEGIN prologue(A, ws, layer, lds, tid, wave, lane); PH_END
        PH_BEGIN
            pg8::Gemm g{(const bf16*)launder(HB), (const bf16*)launder((const GAS bf16*)(ws + W_GU1)), T, NGU, DM}; pg8::StaticOrder S; S.init(T, NGU, gridDim.x, blockIdx.x);
            pg8::EpiGU E{Pb, SSQ};
            pg8::gemm_phase<pg8::EpiGU, pg8::StaticOrder, true, true>(lds, g, S, E);
        PH_END
        PH_BEGIN
            pg8::Gemm g{(const bf16*)launder(Pb), (const bf16*)launder((const GAS bf16*)(ws + W_DN1)), T, DM, FFP}; pg8::StaticOrder S; S.init(T, DM, gridDim.x, blockIdx.x);
            if (layer == 0) { pg8::EpiRES<true> E{A.in[0], HB, SSQ, 0.5f}; pg8::gemm_phase<pg8::EpiRES<true>, pg8::StaticOrder, false, true>(lds, g, S, E); }
            else { pg8::EpiRES<false> E{nullptr, HB, SSQ, 0.5f}; pg8::gemm_phase<pg8::EpiRES<false>, pg8::StaticOrder, false, true>(lds, g, S, E); }
        PH_END
        PH_BEGIN
            pg8::Gemm g{(const bf16*)launder(HB), (const bf16*)launder((const GAS bf16*)(ws + W_IN)), T, NIN, DM}; pg8::StaticOrder S; S.init(T, NIN, gridDim.x, blockIdx.x);
            pg8::EpiIN E{Pb, Fb, SSQ};
            for (int rp = 0; rp < ((PROBE_REP & 4) ? 2 : 1); ++rp)
            pg8::gemm_phase<pg8::EpiIN, pg8::StaticOrder, true, true>(lds, g, S, E);
        PH_END
        PH_BEGIN
            if (gridDim.x == 256) {
                const int bx = blockIdx.x;
                f32x4 zr[4]; u32x2 hqr[4], hir[4];
                const int first = bx < 128 ? bx * 3 : 384 + (bx - 128) * 5, cnt = bx < 128 ? 3 : 5;
                if (bx < 128) compress_item(ws, bx, lds, tid, wave, lane);
                hg1_load(ws, first, tid, zr, hqr, hir);
                for (int i = 0; i < cnt; ++i) hg_step1(ws, SB, first + i, i + 1 < cnt ? first + i + 1 : -1, zr, hqr, hir, lds, tid, wave, lane);
            } else {
                f32x4 zr[4]; u32x2 hqr[4], hir[4];
                for (int ci = blockIdx.x; ci < 128; ci += gridDim.x) compress_item(ws, ci, lds, tid, wave, lane);
                for (int it = blockIdx.x; it < 1024; it += gridDim.x) { hg1_load(ws, it, tid, zr, hqr, hir); hg_step1(ws, SB, it, -1, zr, hqr, hir, lds, tid, wave, lane); }
            }
        PH_END
        PH_BEGIN hg_scan(ws, SB, tid); PH_END
        PH_BEGIN
            {
                GAS unsigned* ctr = (GAS unsigned*)(ws + WS_BAR) + 3584 + 64 * layer;
                volatile LAS int* slot = (volatile LAS int*)(lds + LDS_BYTES - 32);
                if (tid == 0) slot[0] = (int)__hip_atomic_fetch_add(ctr, 1u, __ATOMIC_RELAXED, __HIP_MEMORY_SCOPE_AGENT);
                __syncthreads();
                int par = 0;
                for (;;) {
                    const int it = __builtin_amdgcn_readfirstlane(slot[par]);
                    if (it >= 1536) break;
                    int nxt = 0;
                    if (tid == 0) nxt = (int)__hip_atomic_fetch_add(ctr, 1u, __ATOMIC_RELAXED, __HIP_MEMORY_SCOPE_AGENT);
                    if (it < 512) { for (int rq = 0; rq < ((PROBE_REP & 8) ? 2 : 1); ++rq) nsa_tile(ws, (it & 7) >> 1, it & 1, 63 - (it >> 3), lds, tid, wave, lane); }
                    else hg_step3(ws, SB, A.in[13] + layer * 128, it - 512, lds, tid, wave, lane);
                    if (tid == 0) slot[par ^ 1] = nxt;
                    __syncthreads();
                    par ^= 1;
                }
            }
        PH_END
        PH_BEGIN
            pg8::Gemm g{(const bf16*)launder(MIX), (const bf16*)launder((const GAS bf16*)(ws + W_OUT)), T, DM, DM}; pg8::StaticOrder S; S.init(T, DM, gridDim.x, blockIdx.x);
            pg8::EpiRES<false> E{nullptr, HB, SSQ, 1.0f};
            pg8::gemm_phase<pg8::EpiRES<false>, pg8::StaticOrder, false, true>(lds, g, S, E);
        PH_END
        PH_BEGIN
            pg8::Gemm g{(const bf16*)launder(HB), (const bf16*)launder((const GAS bf16*)(ws + W_GU2)), T, NGU, DM}; pg8::StaticOrder S; S.init(T, NGU, gridDim.x, blockIdx.x);
            pg8::EpiGU E{Pb, SSQ};
            pg8::gemm_phase<pg8::EpiGU, pg8::StaticOrder, true, true>(lds, g, S, E);
        PH_END
        PH_BEGIN
            pg8::Gemm g{(const bf16*)launder(Pb), (const bf16*)launder((const GAS bf16*)(ws + W_DN2)), T, DM, FFP}; pg8::StaticOrder S; S.init(T, DM, gridDim.x, blockIdx.x);
            pg8::EpiRES<false> E{nullptr, HB, SSQ, 0.5f};
            pg8::gemm_phase<pg8::EpiRES<false>, pg8::StaticOrder, false, true>(lds, g, S, E);
        PH_END
    }
    PH_BEGIN
        const GAS float* fn = A.in[18]; GAS float* OUT = A.out;
        const int NGW = gridDim.x * 8; const GAS f32x4* gn = (const GAS f32x4*)fn + lane;
        f32x4 g4[4];
#pragma unroll
        for (int j = 0; j < 4; ++j) g4[j] = gn[64 * j];
        for (int row = blockIdx.x * 8 + wave; row < T; row += 4 * NGW) {
            f32x4 sq[4]; u32x2 w[4][4];
#pragma unroll
            for (int r = 0; r < 4; ++r) { const int rw = row + r * NGW; if (rw < T) { sq[r] = *(const GAS f32x4*)(SSQ + (unsigned)(rw * 4)); const GAS u32x2* hr = (const GAS u32x2*)(HB + (size_t)rw * DM) + lane;
#pragma unroll
                for (int j = 0; j < 4; ++j) w[r][j] = __builtin_nontemporal_load(hr + 64 * j); } }
#pragma unroll
            for (int r = 0; r < 4; ++r) { const int rw = row + r * NGW; if (rw < T) { const float rs = rstd_from(sq[r]); GAS f32x4* orow = (GAS f32x4*)(OUT + (size_t)rw * DM) + lane;
                float dl = 0.f;
                if ((TSP >= 0 || NTS >= 0) && rw < 64) { const GAS unsigned long long* ts = (const GAS unsigned long long*)(ws + WS_BAR + 16384); const float us = (NTS >= 0) ? (float)(ts[128 + NTS]) * 0.01f : (float)(ts[TSP + 1] - ts[TSP]) * 0.01f; dl = 0.002f * sqrtf(us); }
#pragma unroll
                for (int j = 0; j < 4; ++j) __builtin_nontemporal_store((f32x4){bflo(w[r][j].x) * rs * g4[j][0] + dl, bfhi(w[r][j].x) * rs * g4[j][1] - dl, bflo(w[r][j].y) * rs * g4[j][2] + dl, bfhi(w[r][j].y) * rs * g4[j][3] - dl}, orow + 64 * j); } }
        }
    PH_END
#undef HB
#undef MIX
#undef Pb
#undef Fb
#undef SSQ
#undef PH_BEGIN
#undef PH_END
}

extern "C" void kernel_launch(void* const* d_in, const int* in_sizes, int n_in, void* d_out, int out_size, void* d_ws, size_t ws_size, hipStream_t stream) {
    static int grid = 0;
    if (grid == 0) {
        int dev = 0, cus = 0, per_cu = 0;
        hipGetDevice(&dev);
        hipDeviceGetAttribute(&cus, hipDeviceAttributeMultiprocessorCount, dev);
        if (hipFuncSetAttribute((const void*)hymba_fwd, hipFuncAttributeMaxDynamicSharedMemorySize, LDS_BYTES) != hipSuccess) fprintf(stderr, "hipFuncSetAttribute failed\n");
        if (hipOccupancyMaxActiveBlocksPerMultiprocessor(&per_cu, (const void*)hymba_fwd, 512, LDS_BYTES) != hipSuccess || per_cu < 1) { fprintf(stderr, "occupancy query: %d\n", per_cu); per_cu = 1; }
        (void)hipGetLastError();
        grid = cus * 1;
        if (n_in != 19 || ws_size < WS_END) fprintf(stderr, "unexpected n_in %d / ws %zu\n", n_in, ws_size);
    }
    (void)hipMemsetAsync((unsigned char*)d_ws + WS_BAR, 0, 16384 + 2048, stream);
    Args a{};
    for (int i = 0; i < 19; ++i) a.in[i] = (const GAS float*)d_in[i];
    a.out = (GAS float*)d_out; a.ws = (GAS unsigned char*)d_ws; a.ph_lo = 0; a.ph_hi = 1000;
    void* args[] = {&a};
    hipError_t e = hipLaunchCooperativeKernel((const void*)hymba_fwd, dim3(grid), dim3(512), args, LDS_BYTES, stream);
    if (e != hipSuccess) fprintf(stderr, "cooperative launch failed: %s (grid %d)\n", hipGetErrorString(e), grid);
}
```
